# Optimizing an MI355X kernel written in HIP

```python
import math
import jax, jax.numpy as jnp
from jax import lax
import numpy as np

D_MODEL = 2048
BATCH = 4
SEQ = 4096
DEPTH = 1

DN_HEADS = D_MODEL // 256
DN_HEAD_DIM = 128
DN_DIM = DN_HEADS * DN_HEAD_DIM
CONV_WIDTH = 4
CHUNK = 64
DF_HEADS = D_MODEL // 512
DF_HEAD_DIM = 128
DF_DIM = DF_HEADS * 2 * DF_HEAD_DIM
Q_BLOCK = 128
NUM_BUCKETS = 32
MAX_DISTANCE = 128
D_FF = 4 * D_MODEL
IN_COLS = 4 * DN_DIM + 2 * DN_HEADS + 3 * DF_DIM
MIX_WIDTH = DN_DIM + DF_DIM

kernel_name = "hybrid_gdn_diffattn_block"


def rms_norm(x, g, eps=1e-6):
    xf = x.astype(jnp.float32)
    y = xf * lax.rsqrt(jnp.mean(xf * xf, axis=-1, keepdims=True) + eps)
    return (y * g.astype(jnp.float32)).astype(x.dtype)


def l2_norm(x, eps=1e-6):
    xf = x.astype(jnp.float32)
    return xf * lax.rsqrt(jnp.sum(xf * xf, axis=-1, keepdims=True) + eps)


def causal_dwconv(x, w):
    K, C = w.shape
    return lax.conv_general_dilated(
        x, w[:, None, :], window_strides=(1,), padding=[(K - 1, 0)],
        dimension_numbers=("NWC", "WIO", "NWC"), feature_group_count=C)


def t5_causal_bucket(n):
    max_exact = NUM_BUCKETS // 2
    n = jnp.maximum(n, 0)
    nf = jnp.maximum(n, 1).astype(jnp.float32)
    large = max_exact + (jnp.log(nf / max_exact) / math.log(MAX_DISTANCE / max_exact)
                         * (NUM_BUCKETS - max_exact)).astype(jnp.int32)
    large = jnp.minimum(large, NUM_BUCKETS - 1)
    return jnp.where(n < max_exact, n, large)


def gated_delta_rule(q, k, v, g, beta):
    B, S, H, dk = q.shape
    dv = v.shape[-1]
    C = CHUNK
    N = S // C
    f32 = jnp.float32

    def chunks(t):
        t = t.astype(f32).reshape((B, N, C, H) + t.shape[3:])
        perm = (1, 0, 3, 2) + tuple(range(4, t.ndim))
        return t.transpose(perm)

    q = chunks(q) * (dk ** -0.5)
    k = chunks(k)
    v = chunks(v)
    g = chunks(g)
    beta = chunks(beta)

    gc = jnp.cumsum(g, axis=-1)
    tril = jnp.tril(jnp.ones((C, C), dtype=bool))
    strict = jnp.tril(jnp.ones((C, C), dtype=bool), -1)
    decay = jnp.exp(jnp.where(tril, gc[..., :, None] - gc[..., None, :], -jnp.inf))

    kb = k * beta[..., None]
    vb = v * beta[..., None]
    L = jnp.where(strict, jnp.einsum("nbhid,nbhjd->nbhij", kb, k) * decay, 0.0)
    eye = jnp.eye(C, dtype=f32)
    T = lax.linalg.triangular_solve(L + eye, jnp.broadcast_to(eye, L.shape),
                                    left_side=True, lower=True, unit_diagonal=True)
    u = jnp.einsum("nbhij,nbhjd->nbhid", T, vb)
    w = jnp.einsum("nbhij,nbhjd->nbhid", T, kb * jnp.exp(gc)[..., None])
    qk = jnp.where(tril, jnp.einsum("nbhid,nbhjd->nbhij", q, k) * decay, 0.0)

    def step(state, inp):
        qi, ki, ui, wi, gci, qki = inp
        v_new = ui - jnp.einsum("bhck,bhkv->bhcv", wi, state)
        o = (jnp.einsum("bhck,bhkv->bhcv", qi * jnp.exp(gci)[..., None], state)
             + jnp.einsum("bhij,bhjv->bhiv", qki, v_new))
        glast = gci[..., -1]
        kdec = ki * jnp.exp(glast[..., None] - gci)[..., None]
        state = state * jnp.exp(glast)[..., None, None] + jnp.einsum("bhck,bhcv->bhkv", kdec, v_new)
        return state, o

    s0 = jnp.zeros((B, H, dk, dv), f32)
    _, o = lax.scan(step, s0, (q, k, u, w, gc, qk))
    return o.transpose(1, 0, 3, 2, 4).reshape(B, S, H, dv)


def diff_attention(q, k, v, lam, bias_table):
    B, S, H, _, d = q.shape
    NB = S // Q_BLOCK
    qb_all = (q * (d ** -0.5)).reshape(B, NB, Q_BLOCK, H, 2, d).transpose(1, 0, 3, 4, 2, 5)
    kt = k.transpose(0, 2, 3, 1, 4)
    vt = v.transpose(0, 2, 1, 3)
    k_pos = jnp.arange(S)

    def block(args):
        qb, i = args
        q_pos = i * Q_BLOCK + jnp.arange(Q_BLOCK)
        rel = q_pos[:, None] - k_pos[None, :]
        bias = bias_table[t5_causal_bucket(rel)].astype(jnp.float32)
        bias = bias.transpose(2, 0, 1)
        logits = jnp.einsum("bhmqd,bhmkd->bhmqk", qb, kt).astype(jnp.float32)
        logits = logits + bias[None, :, None]
        logits = jnp.where((rel >= 0)[None, None, None], logits, -jnp.inf)
        p = jax.nn.softmax(logits, axis=-1)
        attn = p[:, :, 0] - lam * p[:, :, 1]
        return jnp.einsum("bhqk,bhkv->bhqv", attn.astype(vt.dtype), vt).astype(jnp.float32)

    o = lax.map(block, (qb_all, jnp.arange(NB)))
    return o.transpose(1, 0, 3, 2, 4).reshape(B, S, H, 2 * d)


def setup_inputs(seed: int = 0) -> dict:
    key = jax.random.key(seed)
    ks = jax.random.split(key, 20)
    f32 = jnp.float32
    nrm = lambda k, shape, s: jax.random.normal(k, shape, f32) * s
    x = jax.random.normal(ks[0], (BATCH, SEQ, D_MODEL), f32)
    attn_norm = 1.0 + nrm(ks[1], (DEPTH, D_MODEL), 0.02)
    w_in = nrm(ks[2], (DEPTH, D_MODEL, IN_COLS), D_MODEL ** -0.5)
    conv_w = nrm(ks[3], (DEPTH, CONV_WIDTH, 3 * DN_DIM), CONV_WIDTH ** -0.5)
    a_log = jnp.log(jax.random.uniform(ks[4], (DEPTH, DN_HEADS), f32, 1.0, 16.0))
    dt = jnp.exp(jax.random.uniform(ks[5], (DEPTH, DN_HEADS), f32, math.log(1e-3), math.log(1e-1)))
    dt_bias = dt + jnp.log(-jnp.expm1(-dt))
    dn_norm = 1.0 + nrm(ks[6], (DEPTH, DN_HEAD_DIM), 0.02)
    lambda_q1 = nrm(ks[7], (DEPTH, DF_HEAD_DIM), 0.1)
    lambda_k1 = nrm(ks[8], (DEPTH, DF_HEAD_DIM), 0.1)
    lambda_q2 = nrm(ks[9], (DEPTH, DF_HEAD_DIM), 0.1)
    lambda_k2 = nrm(ks[10], (DEPTH, DF_HEAD_DIM), 0.1)
    df_norm = 1.0 + nrm(ks[11], (DEPTH, 2 * DF_HEAD_DIM), 0.02)
    rel_bias = nrm(ks[12], (NUM_BUCKETS, DF_HEADS), 0.2)
    w_o = nrm(ks[13], (DEPTH, MIX_WIDTH, D_MODEL), MIX_WIDTH ** -0.5)
    mlp_norm = 1.0 + nrm(ks[14], (DEPTH, D_MODEL), 0.02)
    w_up = nrm(ks[15], (DEPTH, D_MODEL, D_FF), D_MODEL ** -0.5)
    w_down = nrm(ks[16], (DEPTH, D_FF, D_MODEL), D_FF ** -0.5)
    final_norm = 1.0 + nrm(ks[17], (D_MODEL,), 0.02)
    return {"x": x, "attn_norm": attn_norm, "w_in": w_in, "conv_w": conv_w,
            "a_log": a_log, "dt_bias": dt_bias, "dn_norm": dn_norm,
            "lambda_q1": lambda_q1, "lambda_k1": lambda_k1,
            "lambda_q2": lambda_q2, "lambda_k2": lambda_k2, "df_norm": df_norm,
            "rel_bias": rel_bias, "w_o": w_o, "mlp_norm": mlp_norm,
            "w_up": w_up, "w_down": w_down, "final_norm": final_norm}


def reference(x, attn_norm, w_in, conv_w, a_log, dt_bias, dn_norm,
              lambda_q1, lambda_k1, lambda_q2, lambda_k2, df_norm,
              rel_bias, w_o, mlp_norm, w_up, w_down, final_norm):
    B, S, _ = x.shape
    f32 = jnp.float32
    sizes = [3 * DN_DIM, DN_DIM, DN_HEADS, DN_HEADS, DF_DIM, DF_DIM, DF_DIM]
    cuts = list(np.cumsum(sizes)[:-1])
    h = x
    for l in range(DEPTH):
        u = rms_norm(h, attn_norm[l])
        proj = jnp.einsum("bsd,de->bse", u, w_in[l])
        dn_qkv, dn_z, dn_b, dn_a, df_q, df_k, df_v = jnp.split(proj, cuts, axis=-1)

        qkv = jax.nn.silu(causal_dwconv(dn_qkv, conv_w[l]))
        q, k, v = jnp.split(qkv, 3, axis=-1)
        q = l2_norm(q.reshape(B, S, DN_HEADS, DN_HEAD_DIM))
        k = l2_norm(k.reshape(B, S, DN_HEADS, DN_HEAD_DIM))
        v = v.reshape(B, S, DN_HEADS, DN_HEAD_DIM)
        beta = jax.nn.sigmoid(dn_b.astype(f32))
        g = -jnp.exp(a_log[l].astype(f32)) * jax.nn.softplus(dn_a.astype(f32) + dt_bias[l].astype(f32))
        o_dn = gated_delta_rule(q, k, v, g, beta)
        z = dn_z.reshape(B, S, DN_HEADS, DN_HEAD_DIM).astype(f32)
        o_dn = rms_norm(o_dn, dn_norm[l]) * jax.nn.silu(z)
        y_dn = o_dn.reshape(B, S, DN_DIM).astype(x.dtype)

        lam_init = 0.8 - 0.6 * math.exp(-0.3 * l)
        lam = (jnp.exp(jnp.sum(lambda_q1[l].astype(f32) * lambda_k1[l].astype(f32)))
               - jnp.exp(jnp.sum(lambda_q2[l].astype(f32) * lambda_k2[l].astype(f32)))
               + lam_init)
        dq = df_q.reshape(B, S, DF_HEADS, 2, DF_HEAD_DIM)
        dk = df_k.reshape(B, S, DF_HEADS, 2, DF_HEAD_DIM)
        dv = df_v.reshape(B, S, DF_HEADS, 2 * DF_HEAD_DIM)
        o_df = diff_attention(dq, dk, dv, lam, rel_bias)
        o_df = rms_norm(o_df, df_norm[l], eps=1e-5) * (1.0 - lam_init)
        y_df = o_df.reshape(B, S, DF_DIM).astype(x.dtype)

        mix = jnp.concatenate([y_dn, y_df], axis=-1)
        h = h + jnp.einsum("bse,ed->bsd", mix, w_o[l])

        u = rms_norm(h, mlp_norm[l])
        hid = jnp.square(jax.nn.relu(jnp.einsum("bsd,df->bsf", u, w_up[l])))
        h = h + jnp.einsum("bsf,fd->bsd", hid, w_down[l])
    return rms_norm(h, final_norm)
```

```cpp
#include <hip/hip_runtime.h>
#include <hip/hip_cooperative_groups.h>
#include <cstdio>
#include <cstdint>
namespace cg = cooperative_groups;

namespace pg8 {
#define PG8_LAS __attribute__((address_space(3)))
typedef unsigned short bf16_t;
typedef short bf16x8 __attribute__((ext_vector_type(8)));
typedef float f32x4 __attribute__((ext_vector_type(4)));
typedef unsigned u32x4 __attribute__((ext_vector_type(4)));
constexpr int BM = 256, BK = 64, HALF = 128, HTB = HALF * BK * 2  , STAGE_BYTES = 8 * HTB, NXCD = 8, WGM = 4;

__host__ __device__ __forceinline__ int lds_byte(int r, int c) { const int st = (r >> 4) * 2 + (c >> 5), rr = r & 15, cc = c & 31, ob = rr * 64 + cc * 2; return st * 1024 + (ob ^ (((ob >> 9) & 1) << 5)); }
__host__ __device__ __forceinline__ void stage_rc(int b, int& R, int& C) { const int st = b / 1024, sb = b % 1024, swz = sb ^ (((sb >> 9) & 1) << 5); R = (st >> 1) * 16 + swz / 64; C = (st & 1) * 32 + (swz % 64) / 2; }
__host__ __device__ __forceinline__ int perm32(int rho) { const int n = rho >> 4, i = rho & 15; return 8 * (i >> 2) + 4 * n + (i & 3); }

struct Unit { int pm, pn; };
struct Gemm { const bf16_t* A; const bf16_t* Bt; int M, N, K; };

struct StaticOrder {
    int nM, nN, nwg, G, c, rev;
    __host__ __device__ void init(int M, int N, int G_, int c_, int rev_ = 0) { nM = M / BM; nN = N / BM; nwg = nM * nN; G = G_; c = c_; rev = rev_; }
    __host__ __device__ bool next(int i, Unit& u) const {
        const long L = (long)i * G + c; if (L >= nwg) return false;
        int wgid = (int)L; { const int q = nwg / NXCD, r = nwg % NXCD, xcd = wgid % NXCD, off = wgid / NXCD; wgid = (xcd < r ? xcd * (q + 1) : r * (q + 1) + (xcd - r) * q) + off; }
        const int nig = WGM * nN, gid = (wgid / nig) ^ rev, fm = gid * WGM, gsz = (nM - fm) < WGM ? (nM - fm) : WGM;
        u.pm = fm + ((wgid % nig) % gsz); u.pn = (wgid % nig) / gsz; return true;
    }
    __device__ __forceinline__ void a_ready(const Unit&) const {}
    __device__ __forceinline__ void done(const Unit&) const {}
};

__device__ __forceinline__ unsigned cvt_pk_bf16(float lo, float hi) { unsigned r; asm volatile("v_cvt_pk_bf16_f32 %0, %1, %2" : "=v"(r) : "v"(lo), "v"(hi)); return r; }
typedef float f32x2 __attribute__((ext_vector_type(2)));
typedef unsigned u32x2e __attribute__((ext_vector_type(2)));
__device__ __forceinline__ u32x4 pack8_bf16(const f32x4 a, const f32x4 b) { u32x4 w; w.x = cvt_pk_bf16(a[0], a[1]); w.y = cvt_pk_bf16(a[2], a[3]); w.z = cvt_pk_bf16(b[0], b[1]); w.w = cvt_pk_bf16(b[2], b[3]); return w; }
struct EpiProj {
    static constexpr bool PERM = true, AFTER_DRAIN = false;
    bf16_t* O; int ldc; int q_lo, q_hi; float qscale;
    __device__ __forceinline__ void operator()(const f32x4 (&acc)[2][2][4][2], const Unit& u, int wr, int wc, int fr, int fq) const {
        const int row0 = u.pm * BM + wr * 64 + fr, col0 = u.pn * BM + wc * 32 + 8 * fq;
        const float sc = (u.pn >= q_lo && u.pn < q_hi) ? qscale : 1.f;
#pragma unroll
        for (int ai = 0; ai < 2; ++ai)
#pragma unroll
            for (int m = 0; m < 4; ++m) { bf16_t* rowp = O + (size_t)(row0 + ai * HALF + m * 16) * ldc + col0;
#pragma unroll
                for (int bj = 0; bj < 2; ++bj) *(u32x4*)(rowp + bj * HALF) = pack8_bf16(acc[ai][bj][m][0] * sc, acc[ai][bj][m][1] * sc); }
    }
};
struct EpiOut {
    static constexpr bool PERM = true, AFTER_DRAIN = false;
    const float* IRS; bf16_t* H1B; float* SS;
    __device__ __forceinline__ void operator()(const f32x4 (&acc)[2][2][4][2], const Unit& u, int wr, int wc, int fr, int fq) const {
        const int row0 = u.pm * BM + wr * 64 + fr, col0 = u.pn * BM + wc * 32 + 8 * fq;
        u32x4 xr2[2][4][2]; float irs[2][4];
#pragma unroll
        for (int ai = 0; ai < 2; ++ai)
#pragma unroll
            for (int m = 0; m < 4; ++m) { const int row = row0 + ai * HALF + m * 16; const size_t off = (size_t)row * 2048 + col0; irs[ai][m] = IRS[row];
#pragma unroll
                for (int bj = 0; bj < 2; ++bj) xr2[ai][m][bj] = *(const u32x4*)(H1B + off + bj * HALF); }
        asm volatile("" ::: "memory");
#pragma unroll
        for (int ai = 0; ai < 2; ++ai)
#pragma unroll
            for (int m = 0; m < 4; ++m) { const int row = row0 + ai * HALF + m * 16; const size_t off = (size_t)row * 2048 + col0; float ss = 0.f; const float s = irs[ai][m];
#pragma unroll
                for (int bj = 0; bj < 2; ++bj) { const u32x4 w = xr2[ai][m][bj];
                    const f32x4 r0 = {__uint_as_float(w.x << 16), __uint_as_float(w.x & 0xffff0000u), __uint_as_float(w.y << 16), __uint_as_float(w.y & 0xffff0000u)};
                    const f32x4 r1 = {__uint_as_float(w.z << 16), __uint_as_float(w.z & 0xffff0000u), __uint_as_float(w.w << 16), __uint_as_float(w.w & 0xffff0000u)};
                    const f32x4 h0 = r0 * s + acc[ai][bj][m][0], h1 = r1 * s + acc[ai][bj][m][1];
                    *(u32x4*)(H1B + off + bj * HALF) = pack8_bf16(h0, h1);
                    ss += (h0[0] * h0[0] + h0[1] * h0[1]) + (h0[2] * h0[2] + h0[3] * h0[3]) + (h1[0] * h1[0] + h1[1] * h1[1]) + (h1[2] * h1[2] + h1[3] * h1[3]); }
                ss += __shfl_xor(ss, 16); ss += __shfl_xor(ss, 32);
                if (fq == 0) SS[(size_t)row * 32 + u.pn * 4 + wc] = ss; }
    }
};
struct EpiUp {
    static constexpr bool PERM = true, AFTER_DRAIN = false;
    bf16_t* O; const PG8_LAS float* rstd_tab; int row_base; const float* SS;
    __device__ __forceinline__ void operator()(const f32x4 (&acc)[2][2][4][2], const Unit& u, int wr, int wc, int fr, int fq) const {
        const int row0 = u.pm * BM + wr * 64 + fr, col0 = u.pn * BM + wc * 32 + 8 * fq;
#pragma unroll
        for (int ai = 0; ai < 2; ++ai)
#pragma unroll
            for (int m = 0; m < 4; ++m) { const int row = row0 + ai * HALF + m * 16;
                float rstd;
                if ((unsigned)(row - row_base) < 2048u) rstd = rstd_tab[row - row_base];
                else { const f32x4* sp = (const f32x4*)(SS + (size_t)row * 32); f32x4 t = sp[0];
#pragma unroll
                    for (int i = 1; i < 8; ++i) t += sp[i];
                    rstd = 1.0f / sqrtf(((t[0] + t[1]) + (t[2] + t[3])) * (1.0f / 2048.0f) + 1e-6f); }
                bf16_t* rowp = O + (size_t)row * 8192 + col0;
#pragma unroll
                for (int bj = 0; bj < 2; ++bj) { f32x4 v0 = acc[ai][bj][m][0] * rstd, v1 = acc[ai][bj][m][1] * rstd;
#pragma unroll
                    for (int e = 0; e < 4; ++e) { v0[e] = fmaxf(v0[e], 0.f); v0[e] *= v0[e]; v1[e] = fmaxf(v1[e], 0.f); v1[e] *= v1[e]; }
                    *(u32x4*)(rowp + bj * HALF) = pack8_bf16(v0, v1); } }
    }
};
struct EpiDown {
    static constexpr bool PERM = true, AFTER_DRAIN = false;
    bf16_t* HB; float* SS;
    __device__ __forceinline__ void operator()(const f32x4 (&acc)[2][2][4][2], const Unit& u, int wr, int wc, int fr, int fq) const {
        const int row0 = u.pm * BM + wr * 64 + fr, col0 = u.pn * BM + wc * 32 + 8 * fq;
#pragma unroll
        for (int ai = 0; ai < 2; ++ai) {
            u32x4 xr[4][2];
#pragma unroll
            for (int m = 0; m < 4; ++m) { const size_t off = (size_t)(row0 + ai * HALF + m * 16) * 2048 + col0;
#pragma unroll
                for (int bj = 0; bj < 2; ++bj) xr[m][bj] = *(const u32x4*)(HB + off + bj * HALF); }
            asm volatile("" ::: "memory");
#pragma unroll
            for (int m = 0; m < 4; ++m) { const int row = row0 + ai * HALF + m * 16; const size_t off = (size_t)row * 2048 + col0; float ss = 0.f;
#pragma unroll
                for (int bj = 0; bj < 2; ++bj) { const u32x4 w = xr[m][bj];
                    const f32x4 r0 = {__uint_as_float(w.x << 16), __uint_as_float(w.x & 0xffff0000u), __uint_as_float(w.y << 16), __uint_as_float(w.y & 0xffff0000u)};
                    const f32x4 r1 = {__uint_as_float(w.z << 16), __uint_as_float(w.z & 0xffff0000u), __uint_as_float(w.w << 16), __uint_as_float(w.w & 0xffff0000u)};
                    const f32x4 h0 = r0 + acc[ai][bj][m][0], h1 = r1 + acc[ai][bj][m][1];
                    *(u32x4*)(HB + off + bj * HALF) = pack8_bf16(h0, h1);
                    ss += (h0[0] * h0[0] + h0[1] * h0[1]) + (h0[2] * h0[2] + h0[3] * h0[3]) + (h1[0] * h1[0] + h1[1] * h1[1]) + (h1[2] * h1[2] + h1[3] * h1[3]); }
                ss += __shfl_xor(ss, 16); ss += __shfl_xor(ss, 32);
                if (fq == 0) SS[(size_t)row * 32 + u.pn * 4 + wc] = ss; }
        }
    }
};
template <class Epi, class Sched, bool ALIGN_EPI = false, bool SP2 = false>
__device__ __forceinline__ void gemm_phase(PG8_LAS unsigned char* lds, const Gemm g, const Sched& S, const Epi& E) {
    const int tid = threadIdx.x, wid = __builtin_amdgcn_readfirstlane(tid >> 6), lane = tid & 63, wr = wid >> 2, wc = wid & 3, fr = lane & 15, fq = lane >> 4;
    const int K = g.K, nt = K / BK;
    unsigned voffA[2], voffB[2];
#pragma unroll
    for (int i = 0; i < 2; ++i) { int R, C; stage_rc(tid * 16 + i * 8192, R, C); const int Rb = Epi::PERM ? ((R & ~31) + perm32(R & 31)) : R;
        voffA[i] = (unsigned)(R * K + C) * 2u; voffB[i] = (unsigned)(Rb * K + C) * 2u; }
    const size_t kstep = (size_t)(BK * 2);
    const size_t hstep = (size_t)HALF * K * 2;
    const size_t tstep = 2 * hstep;
    const unsigned ldsw = (unsigned)wid * 1024u;
    const int aoff = lds_byte(wr * 64 + fr, fq * 8), boff = lds_byte(wc * 32 + fr, fq * 8);
#define PG8_SA(b, h) (((b) * 2 + (h)) * HTB)
#define PG8_SB(b, h) ((4 + (b) * 2 + (h)) * HTB)
#define PG8_STAGE(bufoff, gbase, voff) do { _Pragma("unroll") for (int _i = 0; _i < 2; ++_i) \
        __builtin_amdgcn_global_load_lds((const unsigned*)((const char*)(gbase) + (voff)[_i]), (PG8_LAS unsigned*)(lds + (bufoff) + ldsw + _i * 8192), 16, 0, 0); } while (0)
#define PG8_LDA(dst, b, h) do { _Pragma("unroll") for (int m = 0; m < 4; ++m) _Pragma("unroll") for (int k = 0; k < 2; ++k) dst[m][k] = *(const PG8_LAS bf16x8*)(lds + PG8_SA(b, h) + aoff + m * 2048 + k * 1024); } while (0)
#define PG8_LDB(dst, b, h) do { _Pragma("unroll") for (int n = 0; n < 2; ++n) _Pragma("unroll") for (int k = 0; k < 2; ++k) dst[n][k] = *(const PG8_LAS bf16x8*)(lds + PG8_SB(b, h) + boff + n * 2048 + k * 1024); } while (0)
#define PG8_MMA(ai, bj, At, Bt) do { __builtin_amdgcn_s_setprio(1); _Pragma("unroll") for (int m = 0; m < 4; ++m) _Pragma("unroll") for (int n = 0; n < 2; ++n) _Pragma("unroll") for (int k = 0; k < 2; ++k) \
        acc[ai][bj][m][n] = __builtin_amdgcn_mfma_f32_16x16x32_bf16(Bt[n][k], At[m][k], acc[ai][bj][m][n], 0, 0, 0); __builtin_amdgcn_s_setprio(0); } while (0)
#define PG8_WAIT_V(n) asm volatile("s_waitcnt vmcnt(" #n ")" ::: "memory")
#define PG8_WAIT_L(n) asm volatile("s_waitcnt lgkmcnt(" #n ")" ::: "memory")
#define PG8_BAR __builtin_amdgcn_s_barrier()
#define PG8_SCHED __builtin_amdgcn_sched_barrier(0)
    Unit cur, nxt; int ui = 0;
    if (!S.next(0, cur)) return;
    f32x4 acc[2][2][4][2];
#pragma unroll
    for (int a = 0; a < 2; ++a)
#pragma unroll
        for (int b = 0; b < 2; ++b)
#pragma unroll
            for (int m = 0; m < 4; ++m)
#pragma unroll
                for (int n = 0; n < 2; ++n) acc[a][b][m][n] = (f32x4){0.f, 0.f, 0.f, 0.f};
    bf16x8 At[4][2], B0[2][2], B1[2][2];
    const char* cA = (const char*)g.A + (size_t)cur.pm * tstep; const char* cB = (const char*)g.Bt + (size_t)cur.pn * tstep;
    S.a_ready(cur);
    if constexpr (SP2) {
        PG8_STAGE(PG8_SB(0, 0), cB, voffB); PG8_STAGE(PG8_SB(0, 1), cB + hstep, voffB); PG8_STAGE(PG8_SA(0, 0), cA, voffA); PG8_STAGE(PG8_SA(0, 1), cA + hstep, voffA);
        if (wr == 1) PG8_BAR;
        PG8_WAIT_V(2); PG8_BAR;
        PG8_STAGE(PG8_SB(1, 0), cB + kstep, voffB); PG8_STAGE(PG8_SA(1, 0), cA + kstep, voffA); PG8_STAGE(PG8_SB(1, 1), cB + hstep + kstep, voffB);
        PG8_WAIT_V(6); PG8_BAR;
    } else {
        PG8_STAGE(PG8_SB(0, 0), cB, voffB); PG8_STAGE(PG8_SA(0, 0), cA, voffA); PG8_STAGE(PG8_SB(0, 1), cB + hstep, voffB); PG8_STAGE(PG8_SA(0, 1), cA + hstep, voffA);
        if (wr == 1) PG8_BAR;
        PG8_WAIT_V(4); PG8_BAR;
        PG8_STAGE(PG8_SB(1, 0), cB + kstep, voffB); PG8_STAGE(PG8_SA(1, 0), cA + kstep, voffA); PG8_STAGE(PG8_SB(1, 1), cB + hstep + kstep, voffB);
        PG8_WAIT_V(6); PG8_BAR;
    }
    for (;;) {
        const bool has_next = S.next(ui + 1, nxt);
        const char* nA = has_next ? (const char*)g.A + (size_t)nxt.pm * tstep : cA; const char* nB = has_next ? (const char*)g.Bt + (size_t)nxt.pn * tstep : cB;
        for (int t = 0; t < nt; t += 2) {
            const bool last = (t == nt - 2);
            const char* a1 = cA + (size_t)(t + 1) * kstep;
            const char* a2 = last ? nA : cA + (size_t)(t + 2) * kstep; const char* b2 = last ? nB : cB + (size_t)(t + 2) * kstep;
            const char* a3 = a2 + kstep; const char* b3 = b2 + kstep;
            if (last && has_next) S.a_ready(nxt);
            if constexpr (SP2) {
            PG8_LDB(B0, 0, 0); PG8_LDB(B1, 0, 1); PG8_SCHED; PG8_LDA(At, 0, 0); PG8_STAGE(PG8_SA(1, 1), a1 + hstep, voffA);
            PG8_WAIT_V(8); PG8_WAIT_L(0); PG8_BAR; PG8_MMA(0, 0, At, B0); PG8_MMA(0, 1, At, B1); PG8_BAR; PG8_SCHED;
            PG8_LDA(At, 0, 1); PG8_STAGE(PG8_SB(0, 0), b2, voffB); PG8_STAGE(PG8_SB(0, 1), b2 + hstep, voffB); PG8_STAGE(PG8_SA(0, 0), a2, voffA);
            PG8_WAIT_V(8); PG8_WAIT_L(0); PG8_BAR; PG8_MMA(1, 0, At, B0); PG8_MMA(1, 1, At, B1); PG8_BAR; PG8_SCHED;
            PG8_LDB(B0, 1, 0); PG8_LDB(B1, 1, 1); PG8_SCHED; PG8_LDA(At, 1, 0); PG8_STAGE(PG8_SA(0, 1), a2 + hstep, voffA);
            PG8_WAIT_V(8); PG8_WAIT_L(0); PG8_BAR; PG8_MMA(0, 0, At, B0); PG8_MMA(0, 1, At, B1); PG8_BAR; PG8_SCHED;
            PG8_LDA(At, 1, 1); PG8_STAGE(PG8_SB(1, 0), b3, voffB); PG8_STAGE(PG8_SB(1, 1), b3 + hstep, voffB); PG8_STAGE(PG8_SA(1, 0), a3, voffA);
            PG8_WAIT_V(8); PG8_WAIT_L(0); PG8_BAR; PG8_MMA(1, 0, At, B0); PG8_MMA(1, 1, At, B1); PG8_BAR; PG8_SCHED;
            } else {
            PG8_LDB(B0, 0, 0); PG8_SCHED; PG8_LDA(At, 0, 0); PG8_STAGE(PG8_SA(1, 1), a1 + hstep, voffA);
            PG8_WAIT_L(8); PG8_BAR; PG8_WAIT_L(0); PG8_MMA(0, 0, At, B0); PG8_BAR; PG8_SCHED;
            PG8_LDB(B1, 0, 1); PG8_STAGE(PG8_SB(0, 0), b2, voffB);
            PG8_BAR; PG8_WAIT_L(0); PG8_MMA(0, 1, At, B1); PG8_BAR;
            PG8_LDA(At, 0, 1); PG8_STAGE(PG8_SA(0, 0), a2, voffA);
            PG8_BAR; PG8_WAIT_L(0); PG8_MMA(1, 0, At, B0); PG8_BAR; PG8_SCHED;
            PG8_STAGE(PG8_SB(0, 1), b2 + hstep, voffB);
            PG8_WAIT_V(6); PG8_BAR; PG8_MMA(1, 1, At, B1); PG8_BAR;
            PG8_LDB(B0, 1, 0); PG8_SCHED; PG8_LDA(At, 1, 0); PG8_STAGE(PG8_SA(0, 1), a2 + hstep, voffA);
            PG8_WAIT_L(8); PG8_BAR; PG8_WAIT_L(0); PG8_MMA(0, 0, At, B0); PG8_BAR; PG8_SCHED;
            PG8_LDB(B1, 1, 1); PG8_STAGE(PG8_SB(1, 0), b3, voffB);
            PG8_BAR; PG8_WAIT_L(0); PG8_MMA(0, 1, At, B1); PG8_BAR;
            PG8_LDA(At, 1, 1); PG8_STAGE(PG8_SA(1, 0), a3, voffA);
            PG8_BAR; PG8_WAIT_L(0); PG8_MMA(1, 0, At, B0); PG8_BAR; PG8_SCHED;
            PG8_STAGE(PG8_SB(1, 1), b3 + hstep, voffB);
            PG8_WAIT_V(6); PG8_BAR; PG8_MMA(1, 1, At, B1); PG8_BAR;
            }
        }
        if constexpr (ALIGN_EPI) { if (wr == 0) PG8_BAR; }
        if constexpr (!Epi::AFTER_DRAIN) { E(acc, cur, wr, wc, fr, fq); S.done(cur); }
        if (!has_next) break;
#pragma unroll
        for (int a = 0; a < 2; ++a)
#pragma unroll
            for (int b = 0; b < 2; ++b)
#pragma unroll
                for (int m = 0; m < 4; ++m)
#pragma unroll
                    for (int n = 0; n < 2; ++n) acc[a][b][m][n] = (f32x4){0.f, 0.f, 0.f, 0.f};
        cur = nxt; cA = nA; cB = nB; ++ui;
        if constexpr (ALIGN_EPI) { if (wr == 1) PG8_BAR; }
    }
    PG8_WAIT_V(0);
    if constexpr (!ALIGN_EPI) { if (wr == 0) PG8_BAR; }
    PG8_BAR;
    if constexpr (Epi::AFTER_DRAIN) { E.fused(acc, cur, wr, wc, fr, fq, lds, wid, lane); S.done(cur); }
#undef PG8_SA
#undef PG8_SB
#undef PG8_STAGE
#undef PG8_LDA
#undef PG8_LDB
#undef PG8_MMA
#undef PG8_WAIT_V
#undef PG8_WAIT_L
#undef PG8_BAR
#undef PG8_SCHED
}
}
namespace att {
#define ALAS __attribute__((address_space(3)))
typedef short bf16x8 __attribute__((ext_vector_type(8)));
typedef short s16x4 __attribute__((ext_vector_type(4)));
typedef float f32x16 __attribute__((ext_vector_type(16)));
typedef float f32x4 __attribute__((ext_vector_type(4)));
typedef unsigned u32x4 __attribute__((ext_vector_type(4)));
typedef unsigned short bf16_t;
constexpr int SEQ = 4096, PITCH = 7168, QCOL = 4096, KCOL = 5120, VCOL = 6144, MIXP = 2048;
constexpr int QBLK = 32, KVBLK = 64, QB = 128;
constexpr int TILE_B = 16384;
constexpr int L_WS = 0, L_BIAS = 2048, L_LAM = 6144, L_DFN = 7168, L_TILES = 8192;
constexpr int L_VLO = L_TILES, L_VHI = L_TILES + 2 * TILE_B, L_K1 = L_TILES + 4 * TILE_B, L_K2 = L_TILES + 6 * TILE_B;
constexpr int XROW = 260;
constexpr int LDS_END = L_TILES + 4 * 32 * XROW * 4;
constexpr float LOG2E = 1.4426950408889634f;
constexpr float QSCALE = 0.08838834764831845f * 1.4426950408889634f;

#define KSWZ(row, colB) ((row) * 256 + ((colB) ^ (((row) & 15) << 4)))
#define SBAR() __builtin_amdgcn_sched_barrier(0)
__device__ __forceinline__ int v_st(int k, int c) { const int kk = (k & ~0xC) | ((k & 4) << 1) | ((k & 8) >> 1); return ((kk >> 3) * 4 + (c >> 5)) * 512 + ((kk & 7) * 32 + (c & 31)) * 2; }
__device__ __forceinline__ int v_rd_base(int lane) { return ((lane & 3) << 3) | (((lane >> 2) & 3) << 6) | (((lane >> 4) & 1) << 5) | (((lane >> 5) & 1) << 8); }
constexpr int v_rd_off(int d0, int ks, int half) { return d0 * 512 + ks * 4096 + half * 2048; }
__device__ __forceinline__ int crow(int r, int hi) { return (r & 3) + 8 * (r >> 2) + 4 * hi; }
__device__ __forceinline__ unsigned cvtpk(float lo, float hi) { unsigned r; asm volatile("v_cvt_pk_bf16_f32 %0, %1, %2" : "=v"(r) : "v"(lo), "v"(hi)); return r; }

__device__ __forceinline__ void qkt(f32x16& p0, f32x16& p1, const ALAS char* kt, int r32, int hi, const bf16x8* qr) {
    p0 = f32x16{}; p1 = f32x16{};
    const ALAS char* kb[4];
#pragma unroll
    for (int dd = 0; dd < 4; ++dd) kb[dd] = kt + KSWZ(r32, (dd * 16 + hi * 8) * 2);
#pragma unroll
    for (int d0 = 0; d0 < 8; ++d0) { const ALAS char* a = kb[d0 & 3] + (d0 >> 2) * 128;
        const bf16x8 b0 = *(const ALAS bf16x8*)a;
        const bf16x8 b1 = *(const ALAS bf16x8*)(a + 32 * 256);
        p0 = __builtin_amdgcn_mfma_f32_32x32x16_bf16(b0, qr[d0], p0, 0, 0, 0);
        p1 = __builtin_amdgcn_mfma_f32_32x32x16_bf16(b1, qr[d0], p1, 0, 0, 0); }
}
__device__ __forceinline__ void pv_tile(f32x16* o, unsigned vb, bf16x8 pa0, bf16x8 pa1, bf16x8 pa2, bf16x8 pa3) {
#define TRRD(dst, off) asm volatile("ds_read_b64_tr_b16 %0, %1 offset:%2" : "=&v"(dst) : "v"(vb), "i"(off) : "memory")
#define PV_D0(d0) do { s16x4 l0, l1, l2, l3, h0, h1, h2, h3; constexpr int b_ = v_rd_off(d0, 0, 0); \
        TRRD(l0, b_); TRRD(h0, b_ + 2048); TRRD(l1, b_ + 4096); TRRD(h1, b_ + 6144); TRRD(l2, b_ + 8192); TRRD(h2, b_ + 10240); TRRD(l3, b_ + 12288); TRRD(h3, b_ + 14336); \
        asm volatile("s_waitcnt lgkmcnt(0)" ::: "memory"); SBAR(); \
        o[d0] = __builtin_amdgcn_mfma_f32_32x32x16_bf16(pa0, (bf16x8){l0[0], l0[1], l0[2], l0[3], h0[0], h0[1], h0[2], h0[3]}, o[d0], 0, 0, 0); \
        o[d0] = __builtin_amdgcn_mfma_f32_32x32x16_bf16(pa1, (bf16x8){l1[0], l1[1], l1[2], l1[3], h1[0], h1[1], h1[2], h1[3]}, o[d0], 0, 0, 0); \
        o[d0] = __builtin_amdgcn_mfma_f32_32x32x16_bf16(pa2, (bf16x8){l2[0], l2[1], l2[2], l2[3], h2[0], h2[1], h2[2], h2[3]}, o[d0], 0, 0, 0); \
        o[d0] = __builtin_amdgcn_mfma_f32_32x32x16_bf16(pa3, (bf16x8){l3[0], l3[1], l3[2], l3[3], h3[0], h3[1], h3[2], h3[3]}, o[d0], 0, 0, 0); } while (0)
    PV_D0(0); PV_D0(1); PV_D0(2); PV_D0(3);
#undef PV_D0
#undef TRRD
}

struct AttnArgs { const bf16_t* PROJ; bf16_t* MIX; const float* df_norm; const float* rel_bias; const float* lq1; const float* lk1; const float* lq2; const float* lk2; };

__device__ __forceinline__ void attn_setup(ALAS char* lds, const AttnArgs& A) {
    const int tid = threadIdx.x;
    ALAS float* bt = (ALAS float*)(lds + L_BIAS);
    for (int i = tid; i < 1024; i += 512) { const int h = i >> 8, d = (i & 255) - 64;
      float v = -__builtin_inff();
      if (d >= 0) { int bucket = d;
          if (d >= 16) { const int lg = 16 + (int)(log((double)d / 16.0) / log(8.0) * 16.0); bucket = lg < 31 ? lg : 31; }
          v = (A.rel_bias[bucket * 4 + h] - A.rel_bias[31 * 4 + h]) * LOG2E; }
      bt[i] = v; }
    if (tid >= 256) ((ALAS float*)(lds + L_DFN))[tid - 256] = A.df_norm[tid - 256];
    if (tid < 64) {
        float s1 = A.lq1[tid] * A.lk1[tid] + A.lq1[tid + 64] * A.lk1[tid + 64], s2 = A.lq2[tid] * A.lk2[tid] + A.lq2[tid + 64] * A.lk2[tid + 64];
#pragma unroll
        for (int o = 1; o < 64; o <<= 1) { s1 += __shfl_xor(s1, o); s2 += __shfl_xor(s2, o); }
        if (tid == 0) *(ALAS float*)(lds + L_LAM) = expf(s1) - expf(s2) + 0.2f;
    }
    __syncthreads();
}

__device__ __forceinline__ void attn_unit(ALAS char* lds, const AttnArgs& A, int b, int h, int qb) {
    const int tid = threadIdx.x, wid = __builtin_amdgcn_readfirstlane(tid >> 6), lane = tid & 63, r32 = lane & 31, hi = lane >> 5;
    const int map = wid >> 2, qs = wid & 3;
    const int q0 = qb * QB, R0 = q0 + qs * QBLK;
    const int NT = 2 * qb + 2;
    const size_t rowbase = (size_t)b * SEQ;
    ALAS float* wsf = (ALAS float*)(lds + L_WS) + wid * 64;
    const ALAS float* bt = (const ALAS float*)(lds + L_BIAS) + h * 256;
    const __amdgpu_buffer_rsrc_t rsrc = __builtin_amdgcn_make_buffer_rsrc((void*)A.PROJ, 0, 0x7fffffff, 0x00020000);
    const unsigned voffK = (unsigned)(((lane >> 4) * PITCH + (((lane & 15) ^ (4 * (wid & 3) + (lane >> 4))) * 8)) * 2);
    const int t3 = (lane & 31) >> 2;
    const unsigned voffV = (unsigned)(((8 * ((t3 >> 2) & 1) + (t3 & 3)) * PITCH + 32 * (lane >> 5) + 8 * (lane & 3)) * 2);
    const unsigned soK = (unsigned)(((rowbase + 4 * wid) * PITCH + KCOL + h * 256) * 2);
    const unsigned soV = (unsigned)(((rowbase + 16 * (wid >> 2) + 4 * ((wid >> 1) & 1)) * PITCH + VCOL + h * 256 + 64 * (wid & 1)) * 2);
#define DMA16(ldsoff, voff, soff) __builtin_amdgcn_raw_ptr_buffer_load_lds(rsrc, (ALAS void*)(lds + (ldsoff)), 16, (voff), (soff), 0, 0)
#define ATT_DMA(st_, g_) do { const unsigned tk_ = soK + (unsigned)(st_) * (32 * PITCH * 2), tv_ = soV + (unsigned)(st_) * (32 * PITCH * 2); const int pw_ = (g_) * 8192 + wid * 1024; \
        DMA16(L_K1 + pw_, voffK, tk_); DMA16(L_K2 + pw_, voffK, tk_ + 256); DMA16(L_VLO + pw_, voffV, tv_); DMA16(L_VHI + pw_, voffV, tv_ + 256); } while (0)
#define ATT_DMA_K(st_, g_) do { const unsigned tk_ = soK + (unsigned)(st_) * (32 * PITCH * 2); const int pw_ = (g_) * 8192 + wid * 1024; DMA16(L_K1 + pw_, voffK, tk_); DMA16(L_K2 + pw_, voffK, tk_ + 256); } while (0)
#define ATT_DMA_V(st_, g_) do { const unsigned tv_ = soV + (unsigned)(st_) * (32 * PITCH * 2); const int pw_ = (g_) * 8192 + wid * 1024; DMA16(L_VLO + pw_, voffV, tv_); DMA16(L_VHI + pw_, voffV, tv_ + 256); } while (0)
    bf16x8 qr[8];
    { const bf16_t* qp = A.PROJ + (rowbase + R0 + r32) * PITCH + QCOL + h * 256 + map * 128 + hi * 8;
#pragma unroll
      for (int d0 = 0; d0 < 8; ++d0) qr[d0] = *(const bf16x8*)(qp + d0 * 16); }
    const int NS = 4 * qb + 4;
    ATT_DMA(0, 0); ATT_DMA(1, 1);
    asm volatile("s_waitcnt vmcnt(0)" ::: "memory"); __builtin_amdgcn_s_barrier();
    float m_reg = -1e30f, l_reg = 0.f; f32x16 o[8];
#pragma unroll
    for (int i = 0; i < 8; ++i) o[i] = f32x16{};
    const unsigned vrb_lo = (unsigned)(uintptr_t)(lds) + (unsigned)(L_VLO + v_rd_base(lane)), vrb_hi = vrb_lo + (unsigned)(L_VHI - L_VLO);
    const int qpos = R0 + r32;
#define PK4(P, B_, OUT) do { unsigned a0 = cvtpk(P[B_+0], P[B_+1]), a1 = cvtpk(P[B_+2], P[B_+3]); \
        unsigned b0 = cvtpk(P[B_+4], P[B_+5]), b1 = cvtpk(P[B_+6], P[B_+7]); \
        auto r0 = __builtin_amdgcn_permlane32_swap(a0, b0, false, false); auto r1 = __builtin_amdgcn_permlane32_swap(a1, b1, false, false); \
        u32x4 w = {r0[0], r1[0], r0[1], r1[1]}; OUT = *reinterpret_cast<bf16x8*>(&w); } while (0)
#define TRRD(dst, base, off) asm volatile("ds_read_b64_tr_b16 %0, %1 offset:%2" : "=&v"(dst) : "v"(base), "i"(off) : "memory")
    constexpr float RESC_THR = 8.0f;
    f32x16 p_; float mn_ = 0.f, alpha_ = 1.f; bf16x8 pa0 = bf16x8{}, pa1 = bf16x8{};
#define ATT_H1(kbase, cur, hf) do { \
        p_ = f32x16{}; \
        if (R0 - (kbase) < 144) { const ALAS float* tb_ = bt + (qpos - (kbase) - 4 * hi + 64 - 27); \
            _Pragma("unroll") for (int r = 0; r < 16; ++r) p_[r] = tb_[27 - ((r & 3) + 8 * (r >> 2))]; } \
        __builtin_amdgcn_s_setprio(1); \
        int kd_; asm volatile("v_mov_b32 %0, %1" : "=v"(kd_) : "v"(kdel));     \
        _Pragma("unroll") for (int d0 = 0; d0 < 8; ++d0) { \
            const bf16x8 kf = *(const ALAS bf16x8*)((d0 < 4 ? kfb[d0 & 3] : kfb[d0 & 3] + kd_) + ((cur) * TILE_B + (hf) * 8192)); \
            p_ = __builtin_amdgcn_mfma_f32_32x32x16_bf16(kf, qr[d0], p_, 0, 0, 0); } \
        __builtin_amdgcn_s_setprio(0); \
        float pmax = fmaxf(p_[0], p_[1]); \
        _Pragma("unroll") for (int r = 2; r < 16; ++r) pmax = fmaxf(pmax, p_[r]); \
        { auto rr = __builtin_amdgcn_permlane32_swap(__float_as_uint(pmax), __float_as_uint(pmax), false, false); \
          pmax = fmaxf(__uint_as_float(rr[0]), __uint_as_float(rr[1])); } \
        mn_ = (pmax > m_reg + RESC_THR) ? pmax : m_reg; alpha_ = __builtin_amdgcn_exp2f(m_reg - mn_); m_reg = mn_; } while (0)
#define ATT_H2() do { \
        float ps = 0.f; \
        _Pragma("unroll") for (int r = 0; r < 16; ++r) { p_[r] = __builtin_amdgcn_exp2f(p_[r] - mn_); ps += p_[r]; } \
        { auto rr = __builtin_amdgcn_permlane32_swap(__float_as_uint(ps), __float_as_uint(ps), false, false); \
          ps = __uint_as_float(rr[0]) + __uint_as_float(rr[1]); } \
        l_reg = l_reg * alpha_ + ps; \
        if (__any(alpha_ < 1.f)) { if (hi == 0) wsf[r32] = alpha_; asm volatile("s_waitcnt lgkmcnt(0)" ::: "memory"); \
            _Pragma("unroll") for (int r = 0; r < 16; ++r) { const float a_ = wsf[crow(r, hi)]; \
                _Pragma("unroll") for (int d_ = 0; d_ < 8; ++d_) o[d_][r] *= a_; } } \
        PK4(p_, 0, pa0); PK4(p_, 8, pa1); } while (0)
#define ATT_H3(cur, hf) do { \
        s16x4 la0, ha0, la1, ha1, lb0, hb0, lb1, hb1; __builtin_amdgcn_s_setprio(1); \
        { const int b_ = (cur) * TILE_B + (hf) * 8192; TRRD(la0, vrb_lo, b_); TRRD(ha0, vrb_lo, b_ + 2048); TRRD(la1, vrb_lo, b_ + 4096); TRRD(ha1, vrb_lo, b_ + 6144); } \
        _Pragma("unroll") for (int d_ = 0; d_ < 8; d_ += 2) { \
            { const int b_ = (cur) * TILE_B + (hf) * 8192 + ((d_ + 1) & 3) * 512; const unsigned vb_ = ((d_ + 1) >> 2) ? vrb_hi : vrb_lo; \
              TRRD(lb0, vb_, b_); TRRD(hb0, vb_, b_ + 2048); TRRD(lb1, vb_, b_ + 4096); TRRD(hb1, vb_, b_ + 6144); } \
            asm volatile("s_waitcnt lgkmcnt(4)" ::: "memory"); SBAR(); \
            o[d_] = __builtin_amdgcn_mfma_f32_32x32x16_bf16(pa0, (bf16x8){la0[0], la0[1], la0[2], la0[3], ha0[0], ha0[1], ha0[2], ha0[3]}, o[d_], 0, 0, 0); \
            o[d_] = __builtin_amdgcn_mfma_f32_32x32x16_bf16(pa1, (bf16x8){la1[0], la1[1], la1[2], la1[3], ha1[0], ha1[1], ha1[2], ha1[3]}, o[d_], 0, 0, 0); SBAR(); \
            if (d_ + 2 < 8) { const int b_ = (cur) * TILE_B + (hf) * 8192 + ((d_ + 2) & 3) * 512; const unsigned vb_ = ((d_ + 2) >> 2) ? vrb_hi : vrb_lo; \
              TRRD(la0, vb_, b_); TRRD(ha0, vb_, b_ + 2048); TRRD(la1, vb_, b_ + 4096); TRRD(ha1, vb_, b_ + 6144); \
              asm volatile("s_waitcnt lgkmcnt(4)" ::: "memory"); } else { asm volatile("s_waitcnt lgkmcnt(0)" ::: "memory"); } \
            SBAR(); \
            o[d_ + 1] = __builtin_amdgcn_mfma_f32_32x32x16_bf16(pa0, (bf16x8){lb0[0], lb0[1], lb0[2], lb0[3], hb0[0], hb0[1], hb0[2], hb0[3]}, o[d_ + 1], 0, 0, 0); \
            o[d_ + 1] = __builtin_amdgcn_mfma_f32_32x32x16_bf16(pa1, (bf16x8){lb1[0], lb1[1], lb1[2], lb1[3], hb1[0], hb1[1], hb1[2], hb1[3]}, o[d_ + 1], 0, 0, 0); SBAR(); } \
        __builtin_amdgcn_s_setprio(0); \
    } while (0)
    const ALAS char* kfb[4];
#pragma unroll
    for (int dd = 0; dd < 4; ++dd) kfb[dd] = lds + (map ? L_K2 : L_K1) + KSWZ(r32, (dd * 16 + hi * 8) * 2);
    const int kdel = (r32 & 8) ? -128 : 128;
#define ATT_PAIR(st_, cur) do { const int k0a = (st_) * 32, k0b = k0a + 32; const bool acta_ = k0a <= R0 + QBLK - 1, actb_ = k0b <= R0 + QBLK - 1; \
        const int nxa_ = (st_) + 2 < NS ? (st_) + 2 : NS - 1, nxb_ = (st_) + 3 < NS ? (st_) + 3 : NS - 1; constexpr int ga_ = ((cur) ^ 1) * 2, gb_ = ((cur) ^ 1) * 2 + 1;     \
        if (acta_) { SBAR(); ATT_H1(k0a, cur, 0); SBAR(); } \
        ATT_DMA_K(nxa_, ga_); ATT_DMA_K(nxb_, gb_); \
        if (acta_) { SBAR(); ATT_H2(); SBAR(); } \
        ATT_DMA_V(nxa_, ga_); ATT_DMA_V(nxb_, gb_); \
        if (acta_) { SBAR(); ATT_H3(cur, 0); SBAR(); } \
        if (actb_) { SBAR(); ATT_H1(k0b, cur, 1); SBAR(); ATT_H2(); SBAR(); ATT_H3(cur, 1); } \
        asm volatile("s_waitcnt vmcnt(0) lgkmcnt(0)" ::: "memory"); __builtin_amdgcn_s_barrier(); } while (0)
    for (int st = 0; st < NS; st += 4) { ATT_PAIR(st, 0); ATT_PAIR(st + 2, 1); }
#undef ATT_PAIR
#undef ATT_H1
#undef ATT_H2
#undef ATT_H3
#undef ATT_DMA
#undef ATT_DMA_K
#undef ATT_DMA_V
#undef DMA16
#undef TRRD
#undef PK4

    if (hi == 0) wsf[r32] = l_reg; asm volatile("s_waitcnt lgkmcnt(0)" ::: "memory");
    float rli[16];
#pragma unroll
    for (int r = 0; r < 16; ++r) rli[r] = 1.0f / wsf[crow(r, hi)];
    ALAS float* X = (ALAS float*)(lds + L_TILES) + qs * (32 * XROW);
    if (map == 1) {
#pragma unroll
        for (int d_ = 0; d_ < 8; ++d_) {
#pragma unroll
            for (int r = 0; r < 16; ++r) X[crow(r, hi) * XROW + d_ * 32 + r32] = o[d_][r] * rli[r];
            asm volatile("" ::: "memory"); }
    }
    __syncthreads();
    if (map == 0) {
        const float lam = *(const ALAS float*)(lds + L_LAM);
#pragma unroll
        for (int d_ = 0; d_ < 8; ++d_) {
#pragma unroll
            for (int r = 0; r < 16; ++r) { ALAS float* xp = X + crow(r, hi) * XROW + d_ * 32 + r32; *xp = o[d_][r] * rli[r] - lam * *xp; }
            asm volatile("" ::: "memory"); }
        asm volatile("s_waitcnt lgkmcnt(0)" ::: "memory");
        const int row = lane >> 1, half = lane & 1;
        const ALAS f32x4* xr = (const ALAS f32x4*)(X + row * XROW + half * 128);
        float ss = 0.f;
#pragma unroll 8
        for (int i = 0; i < 32; ++i) { const f32x4 v = xr[i]; ss += (v[0] * v[0] + v[1] * v[1]) + (v[2] * v[2] + v[3] * v[3]); }
        ss += __shfl_xor(ss, 1);
        const float rs = 0.8f / sqrtf(ss * (1.0f / 256.0f) + 1e-5f);
        bf16_t* op = A.MIX + (rowbase + R0 + row) * MIXP + 1024 + h * 256 + half * 128;
        const ALAS float* gn = (const ALAS float*)(lds + L_DFN) + half * 128;
#pragma unroll 4
        for (int i = 0; i < 16; ++i) { const f32x4 v0 = xr[2 * i], v1 = xr[2 * i + 1]; const f32x4 g0 = *(const ALAS f32x4*)(gn + 8 * i), g1 = *(const ALAS f32x4*)(gn + 8 * i + 4);
            u32x4 w; w.x = cvtpk(v0[0] * rs * g0[0], v0[1] * rs * g0[1]); w.y = cvtpk(v0[2] * rs * g0[2], v0[3] * rs * g0[3]);
            w.z = cvtpk(v1[0] * rs * g1[0], v1[1] * rs * g1[1]); w.w = cvtpk(v1[2] * rs * g1[2], v1[3] * rs * g1[3]);
            *(u32x4*)(op + 8 * i) = w; }
    }
    __syncthreads();
}
#undef KSWZ
#undef SBAR
}
namespace dn {
#define DLAS __attribute__((address_space(3)))
typedef short bf16x8 __attribute__((ext_vector_type(8)));
typedef short s16x4 __attribute__((ext_vector_type(4)));
typedef float f32x16 __attribute__((ext_vector_type(16)));
typedef float f32x4 __attribute__((ext_vector_type(4)));
typedef float f32x2_t __attribute__((ext_vector_type(2)));
typedef __bf16 bf16x2_t __attribute__((ext_vector_type(2)));
typedef unsigned u32x4 __attribute__((ext_vector_type(4)));
typedef unsigned u32x2 __attribute__((ext_vector_type(2)));
typedef unsigned short bf16_t;
constexpr int SEQ = 4096, NPC = 7168, NCH = SEQ / 64;
constexpr int IMG_NEGW = 0, IMG_QG = 16384, IMG_KDEC = 32768, IMG_QK = 49152, IMG_BYTES = 55296, IMG_PIECES = 54;
constexpr int U_BYTES = 16384;
constexpr int P_Q = 0, P_K = 16384, P_KT0 = 32768, P_VT0 = 65536, P_T0 = 98304, TP = 68, T_BYTES = 64 * TP * 4, P_ARR0 = P_T0 + 2 * T_BYTES, ARR_BYTES = 1280, P_CW = P_ARR0 + 2 * ARR_BYTES, P_END = P_CW + 3 * 4 * 128 * 4;
constexpr int A_GC = 0, A_BETA = 256, A_BEG = 512, A_DL = 768, A_EGQ = 1024;
constexpr float SCALE = 0.08838834764831845f;

#define KSWZ(row, colB) ((row) * 256 + ((colB) ^ (((row) & 15) << 4)))
__device__ __forceinline__ int v_st(int k, int c) { const int kk = (k & ~0xC) | ((k & 4) << 1) | ((k & 8) >> 1); return ((kk >> 3) * 4 + (c >> 5)) * 512 + ((kk & 7) * 32 + (c & 31)) * 2; }
__device__ __forceinline__ int v_rd_base(int lane) { return ((lane & 3) << 3) | (((lane >> 2) & 3) << 6) | (((lane >> 4) & 1) << 5) | (((lane >> 5) & 1) << 8); }
__device__ __forceinline__ int crow(int r, int hi) { return (r & 3) + 8 * (r >> 2) + 4 * hi; }
__device__ __forceinline__ unsigned cvtpk(float lo, float hi) { f32x2_t v = {lo, hi}; bf16x2_t b = __builtin_convertvector(v, bf16x2_t); return __builtin_bit_cast(unsigned, b); }
__device__ __forceinline__ float bf2f(unsigned short v) { return __uint_as_float((unsigned)v << 16); }
__device__ __forceinline__ bf16x8 pack_regs(const f32x16& x, int s) {
    u32x4 w = {cvtpk(x[8 * s], x[8 * s + 1]), cvtpk(x[8 * s + 2], x[8 * s + 3]), cvtpk(x[8 * s + 4], x[8 * s + 5]), cvtpk(x[8 * s + 6], x[8 * s + 7])};
    return __builtin_bit_cast(bf16x8, w);
}
template <int OFF> __device__ __forceinline__ bf16x8 tr_frag(unsigned vb) {
    s16x4 l, h;
    asm volatile("ds_read_b64_tr_b16 %0, %2 offset:%3\n\tds_read_b64_tr_b16 %1, %2 offset:%4\n\ts_waitcnt lgkmcnt(0)" : "=&v"(l), "=&v"(h) : "v"(vb), "i"(OFF), "i"(OFF + 2048) : "memory");
    return (bf16x8){l[0], l[1], l[2], l[3], h[0], h[1], h[2], h[3]};
}
__device__ __forceinline__ float dpp16_sum(float x) {
    x += __builtin_bit_cast(float, __builtin_amdgcn_update_dpp(0, __builtin_bit_cast(int, x), 0xB1, 0xF, 0xF, true));
    x += __builtin_bit_cast(float, __builtin_amdgcn_update_dpp(0, __builtin_bit_cast(int, x), 0x4E, 0xF, 0xF, true));
    x += __builtin_bit_cast(float, __builtin_amdgcn_update_dpp(0, __builtin_bit_cast(int, x), 0x141, 0xF, 0xF, true));
    x += __builtin_bit_cast(float, __builtin_amdgcn_update_dpp(0, __builtin_bit_cast(int, x), 0x140, 0xF, 0xF, true));
    return x;
}

struct PreArgs { const bf16_t* PROJ; const float* AB; const float* conv_w; const float* a_log; const float* dt_bias; unsigned char* IMG; unsigned char* U; float* EG; };

struct S1Regs { bf16x8 x[11]; float ab0, ab1; };
__device__ __forceinline__ void s1_load(S1Regs& R, const PreArgs& A, int item) {
    const int tid = threadIdx.x, wid = __builtin_amdgcn_readfirstlane(tid >> 6), lane = tid & 63;
    const int bh = item >> 6, n = item & 63, b = bh >> 3, h = bh & 7;
    const size_t m0 = (size_t)b * SEQ + (size_t)n * 64;
    if (wid >= 1 && wid <= 6) {
        const int u = tid - 64, which = u >> 7, run = (u >> 4) & 7, grp = u & 15;
        const bf16_t* src = A.PROJ + (m0 + run * 8 - 3) * NPC + which * 1024 + h * 128 + grp * 8;
        const bool first = (n == 0) && (run == 0);
#pragma unroll
        for (int r = 0; r < 11; ++r) { if (first && r < 3) R.x[r] = bf16x8{}; else R.x[r] = *(const bf16x8*)(src + (size_t)r * NPC); }
    } else if (wid == 7) { R.ab0 = A.AB[(m0 + lane) * 16 + h]; R.ab1 = A.AB[(m0 + lane) * 16 + 8 + h]; }
}
__device__ __forceinline__ void pre_s1(DLAS char* lds, const PreArgs& A, const S1Regs& R, int item, int par) {
    const int tid = threadIdx.x, wid = __builtin_amdgcn_readfirstlane(tid >> 6), lane = tid & 63;
    const int bh = item >> 6, h = bh & 7;
    DLAS char* kt = lds + P_KT0 + par * 16384; DLAS char* vt = lds + P_VT0 + par * 16384; DLAS char* arr = lds + P_ARR0 + par * ARR_BYTES;
    if (wid <= 6) {
        const int u = tid - 64, which = u >> 7, run = (u >> 4) & 7, grp = u & 15, c8 = grp * 8, tok0 = run * 8;
        f32x4 w[4][2];
#pragma unroll
        for (int j = 0; j < 4; ++j) { const DLAS float* wp = (const DLAS float*)(lds + P_CW) + (which * 4 + j) * 128 + c8; w[j][0] = *(const DLAS f32x4*)wp; w[j][1] = *(const DLAS f32x4*)(wp + 4); }
#pragma unroll
        for (int t8 = 0; t8 < 8; ++t8) {
            const int tok = tok0 + t8;
            f32x4 y0 = {0.f, 0.f, 0.f, 0.f}, y1 = {0.f, 0.f, 0.f, 0.f};
#pragma unroll
            for (int j = 0; j < 4; ++j)
#pragma unroll
                for (int e = 0; e < 4; ++e) { y0[e] += w[j][0][e] * bf2f((unsigned short)R.x[t8 + j][e]); y1[e] += w[j][1][e] * bf2f((unsigned short)R.x[t8 + j][4 + e]); }
            float ss = 0.f;
#pragma unroll
            for (int e = 0; e < 4; ++e) { y0[e] = y0[e] * __builtin_amdgcn_rcpf(1.0f + __expf(-y0[e])); y1[e] = y1[e] * __builtin_amdgcn_rcpf(1.0f + __expf(-y1[e])); ss += y0[e] * y0[e] + y1[e] * y1[e]; }
            if (which < 2) { const float rn = __builtin_amdgcn_rsqf(dpp16_sum(ss) + 1e-6f); y0 = y0 * rn; y1 = y1 * rn; }
            const u32x4 pk = {cvtpk(y0[0], y0[1]), cvtpk(y0[2], y0[3]), cvtpk(y1[0], y1[1]), cvtpk(y1[2], y1[3])};
            if (which == 0) *(DLAS u32x4*)(lds + P_Q + KSWZ(tok, c8 * 2)) = pk;
            else if (which == 1) { *(DLAS u32x4*)(lds + P_K + KSWZ(tok, c8 * 2)) = pk; *(DLAS u32x4*)(kt + v_st(tok, c8)) = pk; }
            else *(DLAS u32x4*)(vt + v_st(tok, c8)) = pk;
        }
    } else {
        const float bb = R.ab0, aa = R.ab1;
        const float xx = aa + A.dt_bias[h]; const float sp = xx > 20.f ? xx : log1pf(expf(xx));
        float gc = -expf(A.a_log[h]) * sp;
#pragma unroll
        for (int o = 1; o < 64; o <<= 1) { const float v = __shfl_up(gc, o); if (lane >= o) gc += v; }
        const float glast = __shfl(gc, 63), beta = 1.0f / (1.0f + expf(-bb)), egc = expf(gc);
        ((DLAS float*)(arr + A_GC))[lane] = gc; ((DLAS float*)(arr + A_BETA))[lane] = beta; ((DLAS float*)(arr + A_BEG))[lane] = beta * egc;
        ((DLAS float*)(arr + A_DL))[lane] = expf(glast - gc); ((DLAS float*)(arr + A_EGQ))[lane] = egc * SCALE;
        if (lane == 0) A.EG[item] = expf(glast);
    }
}
__device__ __forceinline__ void pre_s2_job(DLAS char* lds, unsigned char* img, int par, int job, int lane) {
    const int r32 = lane & 31, hi = lane >> 5;
    DLAS char* arr = lds + P_ARR0 + par * ARR_BYTES; const DLAS float* GC = (const DLAS float*)(arr + A_GC);
    DLAS float* T = (DLAS float*)(lds + P_T0 + par * T_BYTES);
    if (job < 6) {
        const bool isL = job < 3; const int tsel = isL ? job : job - 3;
        const int ta = isL ? (tsel >= 1 ? 1 : 0) : (tsel == 2 ? 1 : 0);
        const int tb = isL ? (tsel == 2 ? 1 : 0) : (tsel >= 1 ? 1 : 0);
        f32x16 acc = f32x16{};
        bf16x8 af[8], bfr[8];
#pragma unroll
        for (int d0 = 0; d0 < 8; ++d0) { af[d0] = *(const DLAS bf16x8*)(lds + P_K + KSWZ(32 * ta + r32, (d0 * 16 + hi * 8) * 2)); bfr[d0] = *(const DLAS bf16x8*)(lds + (isL ? P_K : P_Q) + KSWZ(32 * tb + r32, (d0 * 16 + hi * 8) * 2)); }
#pragma unroll
        for (int d0 = 0; d0 < 8; ++d0) acc = __builtin_amdgcn_mfma_f32_32x32x16_bf16(af[d0], bfr[d0], acc, 0, 0, 0);
        const int colx = 32 * tb + r32;
        const float gcol = GC[colx];
        if (isL) {
            const DLAS float* BETA = (const DLAS float*)(arr + A_BETA);
#pragma unroll
            for (int r = 0; r < 16; ++r) { const int i = 32 * ta + crow(r, hi);
                const float v = (colx < i) ? acc[r] * BETA[i] * __expf(GC[i] - gcol) : 0.f;
                T[i * TP + colx] = v; }
        } else {
            f32x16 q;
#pragma unroll
            for (int r = 0; r < 16; ++r) { const int j = 32 * ta + crow(r, hi); q[r] = (j <= colx) ? acc[r] * SCALE * __expf(gcol - GC[j]) : 0.f; }
#pragma unroll
            for (int s = 0; s < 2; ++s) *(bf16x8*)(img + IMG_QK + (tsel * 2 + s) * 1024 + lane * 16) = pack_regs(q, s);
        }
    } else if (job < 8) {
        const DLAS float* EGQ = (const DLAS float*)(arr + A_EGQ);
#pragma unroll
        for (int f = 0; f < 8; ++f) { const int fi = (job - 6) * 8 + f, it = fi >> 3, dkt = (fi >> 1) & 3, s = fi & 1;
            const int i = 32 * it + r32; const float sc = EGQ[i];
            const u32x2 a = *(const DLAS u32x2*)(lds + P_Q + KSWZ(i, (4 * dkt + 2 * s) * 16) + 8 * hi), c = *(const DLAS u32x2*)(lds + P_Q + KSWZ(i, (4 * dkt + 2 * s + 1) * 16) + 8 * hi);
            u32x4 w;
            w.x = cvtpk(__uint_as_float(a.x << 16) * sc, __uint_as_float(a.x & 0xffff0000u) * sc); w.y = cvtpk(__uint_as_float(a.y << 16) * sc, __uint_as_float(a.y & 0xffff0000u) * sc);
            w.z = cvtpk(__uint_as_float(c.x << 16) * sc, __uint_as_float(c.x & 0xffff0000u) * sc); w.w = cvtpk(__uint_as_float(c.y << 16) * sc, __uint_as_float(c.y & 0xffff0000u) * sc);
            *(u32x4*)(img + IMG_QG + ((it * 4 + dkt) * 2 + s) * 1024 + lane * 16) = w; }
    } else {
        const DLAS float* DL = (const DLAS float*)(arr + A_DL);
        const unsigned vb = (unsigned)(uintptr_t)(lds + P_KT0 + par * 16384) + (unsigned)v_rd_base(lane);
#pragma unroll
        for (int q2 = 0; q2 < 2; ++q2) { const int tl = (job - 8) * 2 + q2, dkt = tl >> 1, jt = tl & 1;
            f32x16 acc = f32x16{};
#pragma unroll
            for (int kl = 0; kl < 2; ++kl) {
                const bool on = (kl == (r32 >> 4)) && (hi == ((r32 >> 3) & 1)); const int jj = r32 & 7;
                u32x4 idw = {0u, 0u, 0u, 0u}; const unsigned one = (jj & 1) ? 0x3F800000u : 0x00003F80u;
                if (on) { if ((jj >> 1) == 0) idw.x = one; else if ((jj >> 1) == 1) idw.y = one; else if ((jj >> 1) == 2) idw.z = one; else idw.w = one; }
                const bf16x8 kf = tr_frag<0>(vb + (unsigned)(dkt * 512 + (2 * jt + kl) * 4096));
                __builtin_amdgcn_sched_barrier(0);
                acc = __builtin_amdgcn_mfma_f32_32x32x16_bf16(__builtin_bit_cast(bf16x8, idw), kf, acc, 0, 0, 0);
            }
#pragma unroll
            for (int r = 0; r < 16; ++r) acc[r] *= DL[32 * jt + crow(r, hi)];
#pragma unroll
            for (int s = 0; s < 2; ++s) *(bf16x8*)(img + IMG_KDEC + ((dkt * 2 + jt) * 2 + s) * 1024 + lane * 16) = pack_regs(acc, s);
        }
    }
}
__device__ __forceinline__ void pre_s4(DLAS char* lds, const PreArgs& A, int item, int par) {
    const int tid = threadIdx.x, wid = __builtin_amdgcn_readfirstlane(tid >> 6), lane = tid & 63, r32 = lane & 31, hi = lane >> 5;
    unsigned char* img = A.IMG + (size_t)item * IMG_BYTES;
    DLAS char* arr = lds + P_ARR0 + par * ARR_BYTES; const DLAS float* T = (const DLAS float*)(lds + P_T0 + par * T_BYTES);
    const int it = wid >> 2, d0 = wid & 3;
    const DLAS float* BETA = (const DLAS float*)(arr + A_BETA); const DLAS float* BEG = (const DLAS float*)(arr + A_BEG);
    const unsigned vbV = (unsigned)(uintptr_t)(lds + P_VT0 + par * 16384) + (unsigned)v_rd_base(lane) + (unsigned)(d0 * 512), vbK = (unsigned)(uintptr_t)(lds + P_KT0 + par * 16384) + (unsigned)v_rd_base(lane) + (unsigned)(d0 * 512);
    f32x16 au = f32x16{}, aw = f32x16{};
    const DLAS float* trow = T + (32 * it + r32) * TP + 8 * hi;
#define DN_S4_STEP(ks) do { const f32x4 t0 = *(const DLAS f32x4*)(trow + 16 * (ks)), t1 = *(const DLAS f32x4*)(trow + 16 * (ks) + 4); \
        const f32x4 b0 = *(const DLAS f32x4*)(BETA + 16 * (ks) + 8 * hi), b1 = *(const DLAS f32x4*)(BETA + 16 * (ks) + 8 * hi + 4), g0 = *(const DLAS f32x4*)(BEG + 16 * (ks) + 8 * hi), g1 = *(const DLAS f32x4*)(BEG + 16 * (ks) + 8 * hi + 4); \
        const f32x4 u0 = t0 * b0, u1 = t1 * b1, w0 = t0 * g0, w1 = t1 * g1; \
        const u32x4 tu = {cvtpk(u0[0], u0[1]), cvtpk(u0[2], u0[3]), cvtpk(u1[0], u1[1]), cvtpk(u1[2], u1[3])}, tw = {cvtpk(w0[0], w0[1]), cvtpk(w0[2], w0[3]), cvtpk(w1[0], w1[1]), cvtpk(w1[2], w1[3])}; \
        const bf16x8 vf = tr_frag<(ks) * 4096>(vbV), kf = tr_frag<(ks) * 4096>(vbK); __builtin_amdgcn_sched_barrier(0); \
        au = __builtin_amdgcn_mfma_f32_32x32x16_bf16(__builtin_bit_cast(bf16x8, tu), vf, au, 0, 0, 0); \
        aw = __builtin_amdgcn_mfma_f32_32x32x16_bf16(kf, __builtin_bit_cast(bf16x8, tw), aw, 0, 0, 0); } while (0)
    DN_S4_STEP(0); DN_S4_STEP(1);
    if (it == 1) { DN_S4_STEP(2); DN_S4_STEP(3); }
#undef DN_S4_STEP
    unsigned char* up = A.U + (size_t)item * U_BYTES + (d0 * 2 + it) * 2048 + lane * 32;
    *(bf16x8*)up = pack_regs(au, 0); *(bf16x8*)(up + 16) = pack_regs(au, 1);
#pragma unroll
    for (int r = 0; r < 16; ++r) aw[r] = -aw[r];
#pragma unroll
    for (int s = 0; s < 2; ++s) *(bf16x8*)(img + IMG_NEGW + ((it * 4 + d0) * 2 + s) * 1024 + lane * 16) = pack_regs(aw, s);
}
__device__ __forceinline__ void dn_pre_block(DLAS char* lds, const PreArgs& A, int item0) {
    const int tid = threadIdx.x, wid = __builtin_amdgcn_readfirstlane(tid >> 6), lane = tid & 63;
    { const int h = (item0 >> 6) & 7;
      for (int i = tid; i < 3 * 4 * 128; i += 512) { const int ch = i & 127, j = (i >> 7) & 3, which = i >> 9; ((DLAS float*)(lds + P_CW))[i] = A.conv_w[(size_t)j * 3072 + which * 1024 + h * 128 + ch]; } }
    S1Regs R; R.ab0 = 0.f; R.ab1 = 0.f;
#pragma unroll
    for (int r = 0; r < 11; ++r) R.x[r] = bf16x8{};
    s1_load(R, A, item0);
    __syncthreads();
    for (int k = -1; k < 8; ++k) {
        const int par = k & 1; const bool more = k + 1 < 8, have = k >= 0;
        int zofs; asm volatile("v_mov_b32 %0, 0" : "=v"(zofs));
        DLAS float* T = (DLAS float*)(lds + P_T0 + par * T_BYTES); const DLAS float* Tz = T + zofs;
        if (wid == 0) { if (have) {
                const int half = lane >> 5, c32 = lane & 31;
                const DLAS float* Th = Tz + half * (32 * TP + 32);
                float t[32]; DLAS float* Tw = T + zofs + lane;
#define INVB_LD(buf, i) do { _Pragma("unroll") for (int j4 = 0; j4 < ((i) + 3) / 4; ++j4) buf[j4] = *(const DLAS f32x4*)(Th + (i) * TP + 4 * j4); } while (0)
#define INVB_CP(buf, i) do { float a4[4] = {((i) == c32 + zofs) ? 1.f : 0.f, 0.f, 0.f, 0.f}; \
            _Pragma("unroll") for (int j4 = 0; j4 < ((i) + 3) / 4; ++j4) { _Pragma("unroll") for (int e = 0; e < 4; ++e) if (4 * j4 + e < (i)) a4[e] -= buf[j4][e] * t[4 * j4 + e]; } \
            t[i] = (a4[0] + a4[1]) + (a4[2] + a4[3]); } while (0)
                { f32x4 la[8], lb[8]; INVB_LD(la, 0);
#pragma unroll
                  for (int i = 0; i < 32; i += 2) {
                      INVB_LD(lb, i + 1); __builtin_amdgcn_sched_barrier(0); INVB_CP(la, i); __builtin_amdgcn_sched_barrier(0);
                      if (i + 2 < 32) INVB_LD(la, i + 2); __builtin_amdgcn_sched_barrier(0); INVB_CP(lb, i + 1); __builtin_amdgcn_sched_barrier(0); } }
#undef INVB_LD
#undef INVB_CP
#pragma unroll
                for (int i = 0; i < 32; ++i) Tw[i * TP] = half ? 0.f : t[i];
                if (half) {
#pragma unroll
                    for (int i = 0; i < 32; ++i) Tw[(32 + i) * TP] = t[i]; }
                __builtin_amdgcn_sched_barrier(0);
                f32x16 X = f32x16{}, Dm = f32x16{}; DLAS float* Td = T + zofs + (32 + 4 * half) * TP + c32;
                { const DLAS float* Ab = Tz + (32 + c32) * TP + half;
                  const DLAS float* Bb = Tz + half * TP + c32;
                  float av[16], bv[16];
#pragma unroll
                  for (int s = 0; s < 16; ++s) { av[s] = Ab[2 * s]; bv[s] = Bb[2 * s * TP]; }
                  __builtin_amdgcn_sched_barrier(0);
#pragma unroll
                  for (int s = 0; s < 16; ++s) X = __builtin_amdgcn_mfma_f32_32x32x2f32(av[s], bv[s], X, 0, 0, 0); }
                { const DLAS float* A2 = Tz + (32 + c32) * TP + 32 + 4 * half;
                  float av[16];
#pragma unroll
                  for (int r = 0; r < 16; ++r) av[r] = A2[crow(r, 0)];
                  __builtin_amdgcn_sched_barrier(0);
#pragma unroll
                  for (int r = 0; r < 16; ++r) Dm = __builtin_amdgcn_mfma_f32_32x32x2f32(av[r], X[r], Dm, 0, 0, 0); }
#pragma unroll
                for (int r = 0; r < 16; ++r) Td[crow(r, 0) * TP] = -Dm[r]; } }
        else if (more) { pre_s1(lds, A, R, item0 + k + 1, par ^ 1); if (k + 2 < 8) s1_load(R, A, item0 + k + 2); }
        __syncthreads();
        if (wid == 0) { }
        else if (more) { unsigned char* img1 = A.IMG + (size_t)(item0 + k + 1) * IMG_BYTES;
            for (int jj = 0; jj < 2; ++jj) { if (jj == 1 && wid > 5) break; pre_s2_job(lds, img1, par ^ 1, jj == 0 ? wid - 1 : 6 + wid, lane); } }
        if (have) pre_s4(lds, A, item0 + k, par);
        __syncthreads();
    }
}

constexpr int S_IMG = 0, S_OS = 2 * IMG_BYTES, OSP = 136, S_GN = S_OS + 2 * 64 * OSP * 2, S_END = S_GN + 512;
struct ScanArgs { const unsigned char* IMG; const unsigned char* U; const float* EG; const bf16_t* PROJ; bf16_t* MIX; const float* dn_norm; };
__device__ __forceinline__ void dn_scan(DLAS char* lds, const ScanArgs& A, int bh) {
    const int tid = threadIdx.x, wid = __builtin_amdgcn_readfirstlane(tid >> 6), lane = tid & 63, r32 = lane & 31, hi = lane >> 5;
    const int b = bh >> 3, h = bh & 7;
    const size_t item0 = (size_t)bh * NCH;
    const __amdgpu_buffer_rsrc_t rs = __builtin_amdgcn_make_buffer_rsrc((void*)A.IMG, 0, 0x7fffffff, 0x00020000);
#define SC_DMA(n, bf) do { const unsigned so_ = (unsigned)((item0 + (n)) * IMG_BYTES); \
        _Pragma("unroll") for (int q_ = 0; q_ < 7; ++q_) { const int pc_ = wid + 8 * q_; if (pc_ < IMG_PIECES) \
            __builtin_amdgcn_raw_ptr_buffer_load_lds(rs, (DLAS void*)(lds + S_IMG + (bf) * IMG_BYTES + pc_ * 1024), 16, (unsigned)(lane * 16), so_ + (unsigned)(pc_ * 1024), 0, 0); } } while (0)
    const bool comp = wid < 4;
    const int d0 = wid & 3;
    f32x16 S[4]; bf16x8 Sb[4][2];
#pragma unroll
    for (int i = 0; i < 4; ++i) { S[i] = f32x16{}; Sb[i][0] = bf16x8{}; Sb[i][1] = bf16x8{}; }
    unsigned pf[16]; float egn = 0.f;
#pragma unroll
    for (int i = 0; i < 16; ++i) pf[i] = 0u;
    if (tid < 128) ((DLAS float*)(lds + S_GN))[tid] = A.dn_norm[tid];
#define SC_PREF(n) do { if (comp) { const unsigned char* up_ = A.U + (item0 + (n)) * U_BYTES + (d0 * 2) * 2048 + lane * 32; \
            const u32x4 a_ = *(const u32x4*)up_, b_ = *(const u32x4*)(up_ + 16), c_ = *(const u32x4*)(up_ + 2048), d_ = *(const u32x4*)(up_ + 2048 + 16); egn = A.EG[item0 + (n)]; \
            pf[0] = a_.x; pf[1] = a_.y; pf[2] = a_.z; pf[3] = a_.w; pf[4] = b_.x; pf[5] = b_.y; pf[6] = b_.z; pf[7] = b_.w; pf[8] = c_.x; pf[9] = c_.y; pf[10] = c_.z; pf[11] = c_.w; pf[12] = d_.x; pf[13] = d_.y; pf[14] = d_.z; pf[15] = d_.w; } } while (0)
#define SC_PREFZ(n) do { if (!comp) { _Pragma("unroll") for (int i4 = 0; i4 < 4; ++i4) { const size_t m_ = (size_t)b * SEQ + (size_t)(n) * 64 + (wid - 4) * 16 + 4 * i4 + (lane >> 4); \
            const u32x4 z_ = *(const u32x4*)(A.PROJ + m_ * NPC + 3072 + h * 128 + 8 * (lane & 15)); pf[4 * i4] = z_.x; pf[4 * i4 + 1] = z_.y; pf[4 * i4 + 2] = z_.z; pf[4 * i4 + 3] = z_.w; } } } while (0)
#define SC_NORM(OSB, ZA, cn) do { _Pragma("unroll") for (int i4 = 0; i4 < 4; ++i4) { const int t_ = (wid - 4) * 16 + 4 * i4 + (lane >> 4); \
            const u32x4 ov_ = *(const DLAS u32x4*)((OSB) + t_ * OSP + 8 * (lane & 15)); float of_[8], zf_[8]; \
            of_[0] = __uint_as_float(ov_.x << 16); of_[1] = __uint_as_float(ov_.x & 0xffff0000u); of_[2] = __uint_as_float(ov_.y << 16); of_[3] = __uint_as_float(ov_.y & 0xffff0000u); \
            of_[4] = __uint_as_float(ov_.z << 16); of_[5] = __uint_as_float(ov_.z & 0xffff0000u); of_[6] = __uint_as_float(ov_.w << 16); of_[7] = __uint_as_float(ov_.w & 0xffff0000u); \
            _Pragma("unroll") for (int e_ = 0; e_ < 4; ++e_) { zf_[2 * e_] = __uint_as_float(ZA[4 * i4 + e_] << 16); zf_[2 * e_ + 1] = __uint_as_float(ZA[4 * i4 + e_] & 0xffff0000u); } \
            float ss_ = 0.f; _Pragma("unroll") for (int e_ = 0; e_ < 8; ++e_) ss_ += of_[e_] * of_[e_]; \
            const float rstd_ = __builtin_amdgcn_rsqf(dpp16_sum(ss_) * (1.0f / 128.0f) + 1e-6f); float y_[8]; \
            const f32x4 g0_ = *(const DLAS f32x4*)(lds + S_GN + 32 * (lane & 15)), g1_ = *(const DLAS f32x4*)(lds + S_GN + 32 * (lane & 15) + 16); \
            _Pragma("unroll") for (int e_ = 0; e_ < 8; ++e_) y_[e_] = of_[e_] * rstd_ * (e_ < 4 ? g0_[e_ & 3] : g1_[e_ & 3]) * (zf_[e_] * __builtin_amdgcn_rcpf(1.0f + __expf(-zf_[e_]))); \
            const u32x4 w_ = {cvtpk(y_[0], y_[1]), cvtpk(y_[2], y_[3]), cvtpk(y_[4], y_[5]), cvtpk(y_[6], y_[7])}; \
            *(u32x4*)(A.MIX + ((size_t)b * SEQ + (size_t)(cn) * 64 + t_) * 2048 + h * 128 + 8 * (lane & 15)) = w_; } } while (0)
    SC_PREF(0); SC_DMA(0, 0);
    __syncthreads();
    for (int n = 0; n < NCH; ++n) {
        const int cur = n & 1;
        unsigned pc[16]; const float eg = egn;
#pragma unroll
        for (int i = 0; i < 16; ++i) pc[i] = pf[i];
        if (n + 1 < NCH) SC_PREF(n + 1);
        SC_PREFZ(n);
        if (n + 1 < NCH) SC_DMA(n + 1, cur ^ 1);
        if (comp) {
            const DLAS char* im = lds + S_IMG + cur * IMG_BYTES + lane * 16;
#define FR(off, pc) (*(const DLAS bf16x8*)(im + (off) + (pc) * 1024))
            f32x16 vn[2], o[2];
#pragma unroll
            for (int it = 0; it < 2; ++it) {
#pragma unroll
                for (int e = 0; e < 8; ++e) { const unsigned w = pc[it * 8 + e]; vn[it][2 * e] = __uint_as_float(w << 16); vn[it][2 * e + 1] = __uint_as_float(w & 0xffff0000u); }
            }
            bf16x8 fa[4], fb[4];
#define LD4(dst, off, pc0, cnt) do { _Pragma("unroll") for (int q_ = 0; q_ < (cnt); ++q_) dst[q_] = FR(off, (pc0) + q_); } while (0)
#define SB0() __builtin_amdgcn_sched_barrier(0)
#define MM4(acc, fr, b0, b1, b2, b3) do { acc = __builtin_amdgcn_mfma_f32_32x32x16_bf16(fr[0], b0, acc, 0, 0, 0); acc = __builtin_amdgcn_mfma_f32_32x32x16_bf16(fr[1], b1, acc, 0, 0, 0); \
                acc = __builtin_amdgcn_mfma_f32_32x32x16_bf16(fr[2], b2, acc, 0, 0, 0); acc = __builtin_amdgcn_mfma_f32_32x32x16_bf16(fr[3], b3, acc, 0, 0, 0); } while (0)
            LD4(fa, IMG_NEGW, 0, 4); LD4(fb, IMG_NEGW, 4, 4); SB0();
            MM4(vn[0], fa, Sb[0][0], Sb[0][1], Sb[1][0], Sb[1][1]); SB0(); LD4(fa, IMG_NEGW, 8, 4); SB0();
            MM4(vn[0], fb, Sb[2][0], Sb[2][1], Sb[3][0], Sb[3][1]); SB0(); LD4(fb, IMG_NEGW, 12, 4); SB0();
            MM4(vn[1], fa, Sb[0][0], Sb[0][1], Sb[1][0], Sb[1][1]); SB0(); LD4(fa, IMG_QG, 0, 4); SB0();
            MM4(vn[1], fb, Sb[2][0], Sb[2][1], Sb[3][0], Sb[3][1]); SB0(); LD4(fb, IMG_QG, 4, 4); SB0();
            o[0] = f32x16{}; o[1] = f32x16{};
            MM4(o[0], fa, Sb[0][0], Sb[0][1], Sb[1][0], Sb[1][1]); SB0(); LD4(fa, IMG_QG, 8, 4); SB0();
            MM4(o[0], fb, Sb[2][0], Sb[2][1], Sb[3][0], Sb[3][1]); SB0(); LD4(fb, IMG_QG, 12, 4); SB0();
            bf16x8 vb[2][2];
#pragma unroll
            for (int jt = 0; jt < 2; ++jt) { vb[jt][0] = pack_regs(vn[jt], 0); vb[jt][1] = pack_regs(vn[jt], 1); }
            MM4(o[1], fa, Sb[0][0], Sb[0][1], Sb[1][0], Sb[1][1]); SB0(); LD4(fa, IMG_QK, 0, 4); SB0();
            MM4(o[1], fb, Sb[2][0], Sb[2][1], Sb[3][0], Sb[3][1]); SB0(); LD4(fb, IMG_QK, 4, 2); SB0();
            o[0] = __builtin_amdgcn_mfma_f32_32x32x16_bf16(fa[0], vb[0][0], o[0], 0, 0, 0); o[0] = __builtin_amdgcn_mfma_f32_32x32x16_bf16(fa[1], vb[0][1], o[0], 0, 0, 0);
            o[1] = __builtin_amdgcn_mfma_f32_32x32x16_bf16(fa[2], vb[0][0], o[1], 0, 0, 0); o[1] = __builtin_amdgcn_mfma_f32_32x32x16_bf16(fa[3], vb[0][1], o[1], 0, 0, 0);
            SB0(); LD4(fa, IMG_KDEC, 0, 4); SB0();
            o[1] = __builtin_amdgcn_mfma_f32_32x32x16_bf16(fb[0], vb[1][0], o[1], 0, 0, 0); o[1] = __builtin_amdgcn_mfma_f32_32x32x16_bf16(fb[1], vb[1][1], o[1], 0, 0, 0);
            SB0(); LD4(fb, IMG_KDEC, 4, 4); SB0();
#pragma unroll
            for (int dkt = 0; dkt < 4; ++dkt)
#pragma unroll
                for (int r = 0; r < 16; ++r) S[dkt][r] *= eg;
            MM4(S[0], fa, vb[0][0], vb[0][1], vb[1][0], vb[1][1]); SB0(); LD4(fa, IMG_KDEC, 8, 4); SB0();
            MM4(S[1], fb, vb[0][0], vb[0][1], vb[1][0], vb[1][1]); SB0(); LD4(fb, IMG_KDEC, 12, 4); SB0();
            MM4(S[2], fa, vb[0][0], vb[0][1], vb[1][0], vb[1][1]); SB0();
            MM4(S[3], fb, vb[0][0], vb[0][1], vb[1][0], vb[1][1]);
#pragma unroll
            for (int dkt = 0; dkt < 4; ++dkt) { Sb[dkt][0] = pack_regs(S[dkt], 0); Sb[dkt][1] = pack_regs(S[dkt], 1); }
#undef LD4
#undef SB0
#undef MM4
#undef FR
            DLAS bf16_t* os = (DLAS bf16_t*)(lds + S_OS + cur * (64 * OSP * 2)) + 32 * d0 + r32;
#pragma unroll
            for (int it = 0; it < 2; ++it)
#pragma unroll
                for (int r = 0; r < 16; r += 2) { const unsigned pk = cvtpk(o[it][r], o[it][r + 1]); os[(32 * it + crow(r, hi)) * OSP] = (bf16_t)(pk & 0xffffu); os[(32 * it + crow(r + 1, hi)) * OSP] = (bf16_t)(pk >> 16); }
        } else if (n > 0) {
            const DLAS bf16_t* os = (const DLAS bf16_t*)(lds + S_OS + (cur ^ 1) * (64 * OSP * 2));
            SC_NORM(os, pc, n - 1);
        }
        __syncthreads();
    }
    if (!comp) { const DLAS bf16_t* os = (const DLAS bf16_t*)(lds + S_OS + ((NCH - 1) & 1) * (64 * OSP * 2)); SC_NORM(os, pf, NCH - 1); }
    __syncthreads();
#undef SC_DMA
#undef SC_PREF
#undef SC_PREFZ
#undef SC_NORM
}
#undef KSWZ
}
#define GAS __attribute__((address_space(1)))
#define LAS __attribute__((address_space(3)))
typedef unsigned short bf16;
typedef unsigned v4u __attribute__((ext_vector_type(4)));
typedef float f32x4 __attribute__((ext_vector_type(4)));
typedef short bf16x8 __attribute__((ext_vector_type(8)));
#define LDS_WAIT() asm volatile("s_waitcnt lgkmcnt(0)" ::: "memory")

constexpr int BATCH = 4, SEQ = 4096, DM = 2048, M = BATCH * SEQ, NP = 7168, IN_COLS = 7184, FF = 8192;
constexpr int DNH = 8, DFH = 4;
constexpr int NWAVES = 8;
constexpr int LDS_BYTES = 147456;
constexpr size_t MiB = 1u << 20;
constexpr size_t WS_CTL = 0;
constexpr size_t WS_WIN = 2 * MiB;
constexpr size_t WS_WO = 30 * MiB;
constexpr size_t WS_WUP = 38 * MiB;
constexpr size_t WS_WDN = 70 * MiB;
constexpr size_t WS_AB = 102 * MiB;
constexpr size_t WS_SS1 = 103 * MiB;
constexpr size_t WS_SS2 = 105 * MiB;
constexpr size_t WS_MIX = 108 * MiB;
constexpr size_t WS_BIG = 172 * MiB;
constexpr size_t WS_PROJ = WS_BIG, WS_U = WS_BIG + 224 * MiB, WS_HID = WS_BIG, WS_H1B = WS_BIG + 256 * MiB;
constexpr size_t WS_IRS = 256 * 1024;
constexpr size_t WS_EG = 512 * 1024;
constexpr size_t WS_END = WS_BIG + 320 * MiB;

__device__ __forceinline__ unsigned f2bf(float f) { unsigned u = __builtin_bit_cast(unsigned, f); return (u + 0x7fffu + ((u >> 16) & 1u)) >> 16; }
__device__ __forceinline__ unsigned pk2(float lo, float hi) { unsigned r; asm("v_cvt_pk_bf16_f32 %0, %1, %2" : "=v"(r) : "v"(lo), "v"(hi)); return r; }
__device__ __forceinline__ float bf2f(unsigned short v) { return __builtin_bit_cast(float, (unsigned)v << 16); }
__device__ __forceinline__ float wave_sum(float v) {
    v += __builtin_bit_cast(float, __builtin_amdgcn_update_dpp(0, __builtin_bit_cast(int, v), 0xB1, 0xF, 0xF, true));
    v += __builtin_bit_cast(float, __builtin_amdgcn_update_dpp(0, __builtin_bit_cast(int, v), 0x4E, 0xF, 0xF, true));
    v += __builtin_bit_cast(float, __builtin_amdgcn_update_dpp(0, __builtin_bit_cast(int, v), 0x141, 0xF, 0xF, true));
    v += __builtin_bit_cast(float, __builtin_amdgcn_update_dpp(0, __builtin_bit_cast(int, v), 0x140, 0xF, 0xF, true));
    { auto r = __builtin_amdgcn_permlane32_swap(__float_as_uint(v), __float_as_uint(v), false, false); v = __uint_as_float(r[0]) + __uint_as_float(r[1]); }
    return v + __shfl_xor(v, 16);
}

typedef GAS unsigned gu32;
#define RLX_AGENT __ATOMIC_RELAXED, __HIP_MEMORY_SCOPE_AGENT
#define XB_TMO      128
#define XB_XCNT(j)  (256  + 64 * (j))
#define XB_XSUB(j)  (1280 + 64 * (j))
#define XB_XGEN(j)  (2304 + 64 * (j))
#define XB_TOP      3328
#define XB_TOPGEN   3392
#define XCD_BAR_WORDS 3456
#define XB_SPIN_CAP (1u << 18)

__device__ __forceinline__ unsigned xb_ld(unsigned* p)              { return __hip_atomic_load(p, __ATOMIC_RELAXED, __HIP_MEMORY_SCOPE_AGENT); }
__device__ __forceinline__ unsigned xb_add(unsigned* p, unsigned v) { return __hip_atomic_fetch_add(p, v, __ATOMIC_RELAXED, __HIP_MEMORY_SCOPE_AGENT); }
__device__ __forceinline__ unsigned xb_xcc_id() { return (unsigned)__builtin_amdgcn_s_getreg((3 << 11) | 20) & 0xFu; }
#define XB_SPIN(cond, bar) do { unsigned _sp = 0; while (cond) { __builtin_amdgcn_s_sleep(1); \
    if ((++_sp & 255u) == 0u) { if (xb_ld(&(bar)[XB_TMO])) break; if (_sp > XB_SPIN_CAP) { atomicAdd(&(bar)[XB_TMO], 1u); break; } } } } while (0)

struct XcdBarrier {
    unsigned* bar; unsigned x;
    volatile LAS unsigned* st;
};

__device__ __forceinline__ XcdBarrier xcd_barrier_post(unsigned* bar, volatile LAS unsigned* st) {
    XcdBarrier b; b.bar = bar; b.x = xb_xcc_id(); b.st = st;
    if (threadIdx.x == 0) st[2] = xb_add(&bar[XB_XCNT(b.x)], 1u);
    return b;
}
__device__ __forceinline__ void xcd_barrier_complete(unsigned* bar, unsigned x, unsigned& nloc, unsigned& nx, unsigned& uni) {
    const unsigned G = gridDim.x * gridDim.y * gridDim.z;
    unsigned sum, cnt, mine, sp = 0u, c32;
    for (;;) {
        sum = 0u; cnt = 0u; mine = 0u; c32 = 0u;
#pragma unroll
        for (unsigned j = 0; j < 16; ++j) { const unsigned c = xb_ld(&bar[XB_XCNT(j)]); sum += c; cnt += (c > 0u) ? 1u : 0u; mine = (j == x) ? c : mine; c32 += (j < 8u && c == 32u) ? 1u : 0u; }
        if (sum == G) break;
        __builtin_amdgcn_s_sleep(1);
        if ((++sp & 255u) == 0u) { if (xb_ld(&bar[XB_TMO])) break; if (sp > XB_SPIN_CAP) { atomicAdd(&bar[XB_TMO], 1u); break; } }
    }
    nloc = mine > 0u ? mine : 1u; nx = cnt > 0u ? cnt : 1u;
    uni = (sum == G && G == 256u && c32 == 8u) ? 1u : 0u;
}

__device__ __forceinline__ void xcd_barrier(const XcdBarrier& b) {
    asm volatile("s_waitcnt vmcnt(0)" ::: "memory");
    __syncthreads();
    if (threadIdx.x == 0) {
        unsigned* bar = b.bar;
        __builtin_amdgcn_s_waitcnt(0);
        unsigned nloc = b.st[0], nx = b.st[1];
        if (nloc == 0u) { unsigned uni; xcd_barrier_complete(bar, b.x, nloc, nx, uni); b.st[0] = nloc; b.st[1] = nx; b.st[3] = uni; }
        const unsigned old = xb_add(&bar[XB_XSUB(b.x)], 1u);
        const unsigned gen = old / nloc;
        if (old + 1u == (gen + 1u) * nloc) {
            __builtin_amdgcn_fence(__ATOMIC_RELEASE, "agent");
            asm volatile("s_waitcnt vmcnt(0)" ::: "memory");
            const unsigned og = xb_add(&bar[XB_TOP], 1u);
            const unsigned tg = og / nx;
            if (og + 1u == (tg + 1u) * nx) xb_add(&bar[XB_TOPGEN], 1u);
            else XB_SPIN(xb_ld(&bar[XB_TOPGEN]) == tg, bar);
            __builtin_amdgcn_fence(__ATOMIC_ACQUIRE, "agent");
            xb_add(&bar[XB_XGEN(b.x)], 1u);
            asm volatile("s_waitcnt vmcnt(0)" ::: "memory");
        } else {
            XB_SPIN(xb_ld(&bar[XB_XGEN(b.x)]) == gen, bar);
            __builtin_amdgcn_fence(__ATOMIC_ACQUIRE, "agent");
            asm volatile("s_waitcnt vmcnt(0)" ::: "memory");
        }
    }
    __syncthreads();
}

__device__ __forceinline__ void xcd_barrier_local(const XcdBarrier& b) {
    asm volatile("s_waitcnt vmcnt(0)" ::: "memory");
    __syncthreads();
    if (threadIdx.x == 0) {
        unsigned* bar = b.bar;
        __builtin_amdgcn_s_waitcnt(0);
        const unsigned nloc = b.st[0];
        const unsigned old = xb_add(&bar[XB_XSUB(b.x)], 1u);
        const unsigned gen = old / nloc;
        if (old + 1u == (gen + 1u) * nloc) xb_add(&bar[XB_XGEN(b.x)], 1u);
        else XB_SPIN(xb_ld(&bar[XB_XGEN(b.x)]) == gen, bar);
        __builtin_amdgcn_fence(__ATOMIC_ACQUIRE, "agent");
        asm volatile("s_waitcnt vmcnt(0)" ::: "memory");
    }
    __syncthreads();
}

constexpr size_t WS_BAR = 64 * 1024;
constexpr int LDS_MISC = LDS_BYTES - 64;
struct Frame {
    LAS unsigned char* lds;
    int tid, lane, wave, G, bid, cv, uni;
    const float* in[18]; float* out; unsigned char* ws;
};

__device__ __forceinline__ void p0_transpose_item(const float* W, int ldw, int K, bf16* WT, int k0, int csrc, int ndst, const float* ksc, LAS float* scr, int lane) {
    float wv[32];
#pragma unroll
    for (int i = 0; i < 32; ++i) wv[i] = W[(size_t)(k0 + 2 * i + (lane >> 5)) * ldw + csrc + (lane & 31)];
    if (ksc) {
#pragma unroll
        for (int i = 0; i < 32; ++i) wv[i] *= ksc[k0 + 2 * i + (lane >> 5)]; }
#pragma unroll
    for (int i = 0; i < 32; ++i) scr[(2 * i + (lane >> 5)) * 33 + (lane & 31)] = wv[i];
    LDS_WAIT(); asm volatile("" ::: "memory");
    const int c = lane & 7;
#pragma unroll
    for (int j = 0; j < 4; ++j) { const int n = (lane >> 3) + 8 * j; const LAS float* s = scr + (8 * c) * 33 + n;
        v4u o; o.x = pk2(s[0 * 33], s[1 * 33]); o.y = pk2(s[2 * 33], s[3 * 33]); o.z = pk2(s[4 * 33], s[5 * 33]); o.w = pk2(s[6 * 33], s[7 * 33]);
        *(GAS v4u*)(WT + (size_t)(ndst + n) * K + k0 + 8 * c) = o; }
    LDS_WAIT(); asm volatile("" ::: "memory");
}
constexpr int I_IN = (DM / 64) * (NP / 32), I_O = (DM / 64) * (DM / 32), I_UP = (DM / 64) * (FF / 32), I_DN = (FF / 64) * (DM / 32), NITEMS = I_IN + I_O + I_UP + I_DN;
__device__ __forceinline__ void p0_convert(Frame& F, int it_lo, int it_hi, int gw, int nw) {
    const float* w_in = F.in[2]; const float* w_o = F.in[13]; const float* mlp_norm = F.in[14]; const float* w_up = F.in[15]; const float* w_down = F.in[16];
    bf16* WIN = (bf16*)(F.ws + WS_WIN); bf16* WO = (bf16*)(F.ws + WS_WO); bf16* WUP = (bf16*)(F.ws + WS_WUP); bf16* WDN = (bf16*)(F.ws + WS_WDN);
    LAS float* scr = (LAS float*)(F.lds + F.wave * 16384);
    for (int it = it_lo + gw; it < it_hi; it += nw) {
        int r = it;
        if (r < I_IN) { const int nblk = NP / 32, kb = r / nblk, nb = r % nblk, n0 = 32 * nb; p0_transpose_item(w_in, IN_COLS, DM, WIN, 64 * kb, n0 + (n0 >= 4096 ? 16 : 0), n0, F.in[1], scr, F.lane); continue; } r -= I_IN;
        if (r < I_O) { const int nblk = DM / 32, kb = r / nblk, nb = r % nblk; p0_transpose_item(w_o, DM, DM, WO, 64 * kb, 32 * nb, 32 * nb, nullptr, scr, F.lane); continue; } r -= I_O;
        if (r < I_UP) { const int nblk = FF / 32, kb = r / nblk, nb = r % nblk; p0_transpose_item(w_up, FF, DM, WUP, 64 * kb, 32 * nb, 32 * nb, mlp_norm, scr, F.lane); continue; } r -= I_UP;
        { const int nblk = DM / 32, kb = r / nblk, nb = r % nblk; p0_transpose_item(w_down, DM, FF, WDN, 64 * kb, 32 * nb, 32 * nb, nullptr, scr, F.lane); }
    }
}
struct TItem { const float* W; bf16* WT; const float* ksc; int ldw, K, k0, csrc, ndst; };
__device__ __forceinline__ void p0_item_decode(Frame& F, int it, TItem& t) {
    int r = it;
    if (r < I_IN) { const int nblk = NP / 32, kb = r / nblk, nb = r % nblk, n0 = 32 * nb; t = TItem{F.in[2], (bf16*)(F.ws + WS_WIN), F.in[1], IN_COLS, DM, 64 * kb, n0 + (n0 >= 4096 ? 16 : 0), n0}; return; } r -= I_IN;
    if (r < I_O) { const int nblk = DM / 32, kb = r / nblk, nb = r % nblk; t = TItem{F.in[13], (bf16*)(F.ws + WS_WO), nullptr, DM, DM, 64 * kb, 32 * nb, 32 * nb}; return; } r -= I_O;
    if (r < I_UP) { const int nblk = FF / 32, kb = r / nblk, nb = r % nblk; t = TItem{F.in[15], (bf16*)(F.ws + WS_WUP), F.in[14], FF, DM, 64 * kb, 32 * nb, 32 * nb}; return; } r -= I_UP;
    { const int nblk = DM / 32, kb = r / nblk, nb = r % nblk; t = TItem{F.in[16], (bf16*)(F.ws + WS_WDN), nullptr, DM, FF, 64 * kb, 32 * nb, 32 * nb}; }
}
__device__ __forceinline__ void p0_item_load(const TItem& t, float (&wv)[32], int lane) {
#pragma unroll
    for (int i = 0; i < 32; ++i) wv[i] = t.W[(size_t)(t.k0 + 2 * i + (lane >> 5)) * t.ldw + t.csrc + (lane & 31)];
}
__device__ __forceinline__ void p0_item_store(const TItem& t, float (&wv)[32], LAS float* scr, int lane) {
    if (t.ksc) {
#pragma unroll
        for (int i = 0; i < 32; ++i) wv[i] *= t.ksc[t.k0 + 2 * i + (lane >> 5)]; }
#pragma unroll
    for (int i = 0; i < 32; ++i) scr[(2 * i + (lane >> 5)) * 33 + (lane & 31)] = wv[i];
    LDS_WAIT(); asm volatile("" ::: "memory");
    const int c = lane & 7;
#pragma unroll
    for (int j = 0; j < 4; ++j) { const int n = (lane >> 3) + 8 * j; const LAS float* s = scr + (8 * c) * 33 + n;
        v4u o; o.x = pk2(s[0 * 33], s[1 * 33]); o.y = pk2(s[2 * 33], s[3 * 33]); o.z = pk2(s[4 * 33], s[5 * 33]); o.w = pk2(s[6 * 33], s[7 * 33]);
        *(GAS v4u*)(t.WT + (size_t)(t.ndst + n) * t.K + t.k0 + 8 * c) = o; }
    LDS_WAIT(); asm volatile("" ::: "memory");
}
__device__ __forceinline__ void p0_convert_pipe(Frame& F, int it_lo, int it_hi, int gw, int nw) {
    LAS float* scr = (LAS float*)(F.lds + F.wave * 16384);
    TItem t0{}, t1{}, t2{}, t3{}; float w0[32], w1[32], w2[32], w3[32]; int it = it_lo + gw;
#define CV_LD(t, w, i) do { if ((i) < it_hi) { p0_item_decode(F, (i), t); p0_item_load(t, w, F.lane); } } while (0)
#define CV_ST(t, w, i) do { if ((i) < it_hi) p0_item_store(t, w, scr, F.lane); } while (0)
    CV_LD(t0, w0, it); CV_LD(t1, w1, it + nw); CV_LD(t2, w2, it + 2 * nw);
    while (it < it_hi) {
        CV_LD(t3, w3, it + 3 * nw); CV_ST(t0, w0, it);
        CV_LD(t0, w0, it + 4 * nw); CV_ST(t1, w1, it + nw);
        CV_LD(t1, w1, it + 5 * nw); CV_ST(t2, w2, it + 2 * nw);
        CV_LD(t2, w2, it + 6 * nw); CV_ST(t3, w3, it + 3 * nw);
        it += 4 * nw;
    }
#undef CV_LD
#undef CV_ST
}
constexpr int CONV_B0 = 32, CONV_NB = 64;
__device__ __forceinline__ void p0_prologue(Frame& F) {
    const float* x = F.in[0]; const float* attn_norm = F.in[1]; const float* w_in = F.in[2];
    bf16* XN = (bf16*)(F.ws + WS_H1B); float* AB = (float*)(F.ws + WS_AB); float* IRS = (float*)(F.ws + WS_IRS);
    if (F.bid == 0 && F.tid == 0) *(unsigned*)(F.ws + WS_CTL) = 0u;
    const int gw = F.bid * NWAVES + F.wave, NGW = F.G * NWAVES;
    p0_convert(F, 0, F.G >= CONV_B0 + CONV_NB ? I_IN : NITEMS, gw, NGW);
    __syncthreads();
    LAS float* WAB = (LAS float*)F.lds;
    { f32x4 wv[16];
#pragma unroll
      for (int q = 0; q < 16; ++q) { const int i = F.tid + q * (NWAVES * 64), k = i >> 2, c4 = i & 3; wv[q] = *(const f32x4*)(w_in + (size_t)k * IN_COLS + 4096 + 4 * c4); }
      __builtin_amdgcn_sched_barrier(0);
#pragma unroll
      for (int q = 0; q < 16; ++q) { const int i = F.tid + q * (NWAVES * 64), k = i >> 2, c4 = i & 3;
          WAB[(4 * c4 + 0) * DM + k] = wv[q][0]; WAB[(4 * c4 + 1) * DM + k] = wv[q][1]; WAB[(4 * c4 + 2) * DM + k] = wv[q][2]; WAB[(4 * c4 + 3) * DM + k] = wv[q][3]; } }
    __syncthreads();
    f32x4 g4[8];
#pragma unroll
    for (int j = 0; j < 8; ++j) g4[j] = *(const f32x4*)(attn_norm + 4 * F.lane + 256 * j);
    for (int m = gw; m < M; m += NGW) {
        const f32x4* xr = (const f32x4*)(x + (size_t)m * DM) + F.lane;
        f32x4 v[8]; float s = 0.f;
#pragma unroll
        for (int j = 0; j < 8; ++j) { v[j] = xr[64 * j]; s += (v[j][0] * v[j][0] + v[j][1] * v[j][1]) + (v[j][2] * v[j][2] + v[j][3] * v[j][3]); }
        const float rstd = 1.0f / sqrtf(wave_sum(s) * (1.0f / DM) + 1e-6f);
        unsigned long long* o8 = (unsigned long long*)(XN + (size_t)m * DM) + F.lane;
#pragma unroll
        for (int j = 0; j < 8; ++j) { v[j] = v[j] * rstd; o8[64 * j] = (unsigned long long)pk2(v[j][0], v[j][1]) | ((unsigned long long)pk2(v[j][2], v[j][3]) << 32); v[j] = v[j] * g4[j]; }
        if (F.lane == 0) IRS[m] = 1.0f / rstd;
        float a16[16];
#pragma unroll
        for (int c = 0; c < 16; ++c) { const LAS f32x4* wp = (const LAS f32x4*)(WAB + c * DM) + F.lane; float a = 0.f;
#pragma unroll
            for (int j = 0; j < 8; ++j) { const f32x4 w = wp[64 * j]; a += (v[j][0] * w[0] + v[j][1] * w[1]) + (v[j][2] * w[2] + v[j][3] * w[3]); }
            a16[c] = a; if ((c & 1) == 1) __builtin_amdgcn_sched_barrier(0); }
        float b8[8];
#pragma unroll
        for (int i = 0; i < 8; ++i) { auto r = __builtin_amdgcn_permlane32_swap(__float_as_uint(a16[i]), __float_as_uint(a16[i + 8]), false, false);
            b8[i] = __uint_as_float(r[0]) + __uint_as_float(r[1]); }
#pragma unroll
        for (int i = 0; i < 8; ++i) {
            float x = b8[i];
            x += __builtin_bit_cast(float, __builtin_amdgcn_update_dpp(0, __builtin_bit_cast(int, x), 0xB1, 0xF, 0xF, true));
            x += __builtin_bit_cast(float, __builtin_amdgcn_update_dpp(0, __builtin_bit_cast(int, x), 0x4E, 0xF, 0xF, true));
            x += __builtin_bit_cast(float, __builtin_amdgcn_update_dpp(0, __builtin_bit_cast(int, x), 0x141, 0xF, 0xF, true));
            x += __builtin_bit_cast(float, __builtin_amdgcn_update_dpp(0, __builtin_bit_cast(int, x), 0x140, 0xF, 0xF, true));
            b8[i] = x; }
        float mine = 0.f;
#pragma unroll
        for (int i = 0; i < 8; ++i) { const float t = b8[i] + __shfl_xor(b8[i], 16); if ((F.lane & 7) == i) mine = t; }
        if ((F.lane & 31) < 8) AB[(size_t)m * 16 + (F.lane >> 5) * 8 + (F.lane & 7)] = mine;
    }
}

__device__ __forceinline__ void final_norm_phase(Frame& F) {
    const float* SS2 = (const float*)(F.ws + WS_SS2); const float* fn = F.in[17]; const bf16* HB = (const bf16*)(F.ws + WS_H1B);
    const int gw = F.bid * NWAVES + F.wave, NGW = F.G * NWAVES;
    f32x4 g4[4][2];
#pragma unroll
    for (int j = 0; j < 4; ++j) { g4[j][0] = *(const f32x4*)(fn + 512 * j + 8 * F.lane); g4[j][1] = *(const f32x4*)(fn + 512 * j + 8 * F.lane + 4); }
    const int rowb = F.uni ? 2048 * (F.cv & 7) + (F.cv >> 3) * NWAVES + F.wave : gw, rows = F.uni ? 256 : NGW;
    for (int m0 = rowb; m0 < (F.uni ? rowb + 1 : M); m0 += 8 * NGW) {
        v4u w[8][4]; float part[8];
#pragma unroll
        for (int i = 0; i < 8; ++i) { const int m = m0 + i * rows < M ? m0 + i * rows : m0; const v4u* hr = (const v4u*)(HB + (size_t)m * DM) + F.lane;
#pragma unroll
            for (int j = 0; j < 4; ++j) w[i][j] = hr[64 * j];
            part[i] = F.lane < 32 ? SS2[(size_t)m * 32 + F.lane] : 0.f; }
#pragma unroll
        for (int i = 0; i < 8; ++i) { const int m = m0 + i * rows; if (m >= M) break;
            const float rstd = 1.0f / sqrtf(wave_sum(part[i]) * (1.0f / DM) + 1e-6f);
            float* orow = F.out + (size_t)m * DM + 8 * F.lane;
#pragma unroll
            for (int j = 0; j < 4; ++j) {
                const f32x4 r0 = {__uint_as_float(w[i][j].x << 16), __uint_as_float(w[i][j].x & 0xffff0000u), __uint_as_float(w[i][j].y << 16), __uint_as_float(w[i][j].y & 0xffff0000u)};
                const f32x4 r1 = {__uint_as_float(w[i][j].z << 16), __uint_as_float(w[i][j].z & 0xffff0000u), __uint_as_float(w[i][j].w << 16), __uint_as_float(w[i][j].w & 0xffff0000u)};
                *(f32x4*)(orow + 512 * j) = r0 * rstd * g4[j][0]; *(f32x4*)(orow + 512 * j + 4) = r1 * rstd * g4[j][1]; } }
    }
}

constexpr int NPHASE = 8;
struct Args { const float* in[18]; float* out; unsigned char* ws; int ph_lo, ph_hi; };
__global__ void __launch_bounds__(NWAVES * 64, 2) fwd_kernel(Args args) {
    extern __shared__ __attribute__((aligned(16))) unsigned char lds_raw[];
    Frame F;
    asm volatile("s_nop 0\n\ts_nop 0\n\ts_nop 0\n\ts_nop 0\n\ts_nop 0\n\ts_nop 0\n\ts_nop 0\n\ts_nop 0\n\ts_nop 0\n\ts_nop 0\n\ts_nop 0\n\ts_nop 0");
    F.lds = (LAS unsigned char*)lds_raw;
    F.tid = threadIdx.x; F.lane = F.tid & 63; F.wave = __builtin_amdgcn_readfirstlane(F.tid >> 6); F.G = gridDim.x; F.bid = blockIdx.x;
#pragma unroll
    for (int i = 0; i < 18; ++i) F.in[i] = args.in[i];
    F.out = args.out; F.ws = args.ws;
    const int lo = args.ph_lo, hi = args.ph_hi;
#ifndef PROBE_REP
#define PROBE_REP -1
#endif
#define IN(k) (lo <= (k) && (k) < hi)
#define REP(k) for (int rep_ = 0; rep_ < ((k) == PROBE_REP ? 2 : 1); ++rep_)
#define SEAM(k) do { if (IN(k) && IN((k) + 1)) { xcd_barrier(bar); } } while (0)
    { volatile LAS unsigned* st = (volatile LAS unsigned*)(F.lds + LDS_MISC); if (F.tid < 4) st[F.tid] = 0u; }
    __syncthreads();
    XcdBarrier bar = xcd_barrier_post((unsigned*)(F.ws + WS_BAR), (volatile LAS unsigned*)(F.lds + LDS_MISC));
    if (lo > 1000) cg::this_grid().sync();
    bf16* PROJ = (bf16*)(F.ws + WS_PROJ);
    F.cv = F.bid; F.uni = 0;
    if (IN(0)) REP(0) { p0_prologue(F); } SEAM(0);
    if (IN(0) && IN(1)) { volatile LAS unsigned* st = (volatile LAS unsigned*)(F.lds + LDS_MISC); F.uni = (int)st[3]; if (F.uni) F.cv = (int)(bar.x + 8u * st[2]); }
#define SEAML(k) do { if (IN(k) && IN((k) + 1)) { if (F.uni) xcd_barrier_local(bar); else xcd_barrier(bar); } } while (0)
    if (IN(1)) REP(1) {
        pg8::Gemm g{(const pg8::bf16_t*)(F.ws + WS_H1B), (const pg8::bf16_t*)(F.ws + WS_WIN), M, NP, DM}; pg8::StaticOrder S; S.init(M, NP, F.G, F.cv);
        pg8::EpiProj E{PROJ, NP, 16, 20, att::QSCALE};
        pg8::gemm_phase<pg8::EpiProj, pg8::StaticOrder, true, true>(F.lds, g, S, E);
    } SEAM(1);
    if (IN(2)) REP(2) {
        dn::PreArgs A{PROJ, (const float*)(F.ws + WS_AB), F.in[3], F.in[4], F.in[5], (unsigned char*)F.out, F.ws + WS_U, (float*)(F.ws + WS_EG)};
        for (int it = F.bid * 8; it < BATCH * DNH * 64; it += F.G * 8) dn::dn_pre_block((LAS char*)F.lds, A, it);
    }
    unsigned* p2ctl = (unsigned*)(F.ws + WS_CTL + 4096);
    if (IN(2) && IN(3)) {
        asm volatile("s_waitcnt vmcnt(0)" ::: "memory"); __syncthreads();
        if (F.tid == 0) { const unsigned nloc = bar.st[0];
            if (xb_add(&p2ctl[64 * bar.x], 1u) + 1u == nloc) { __builtin_amdgcn_fence(__ATOMIC_RELEASE, "agent"); asm volatile("s_waitcnt vmcnt(0)" ::: "memory"); (void)xb_add(&p2ctl[1024], 1u); } }
    }
    if (IN(3)) REP(3) {
        if (F.bid < BATCH * DNH) {
            if (IN(2)) {
                if (F.tid == 0) { const unsigned nx = bar.st[1]; XB_SPIN(xb_ld(&p2ctl[1024]) < nx, bar.bar); __builtin_amdgcn_fence(__ATOMIC_ACQUIRE, "agent"); asm volatile("s_waitcnt vmcnt(0)" ::: "memory"); }
                __syncthreads();
            }
            dn::ScanArgs SA{(const unsigned char*)F.out, F.ws + WS_U, (const float*)(F.ws + WS_EG), PROJ, (bf16*)(F.ws + WS_MIX), F.in[6]};
            dn::dn_scan((LAS char*)F.lds, SA, F.bid);
        }
        if (F.G >= CONV_B0 + CONV_NB && F.bid >= CONV_B0 && F.bid < CONV_B0 + CONV_NB) {
            p0_convert_pipe(F, I_IN, NITEMS, (F.bid - CONV_B0) * NWAVES + F.wave, CONV_NB * NWAVES);
            __syncthreads();
        }
        att::AttnArgs A{PROJ, (bf16*)(F.ws + WS_MIX), F.in[11], F.in[12], F.in[7], F.in[8], F.in[9], F.in[10]};
        att::attn_setup((LAS char*)F.lds, A);
        unsigned* qctr = (unsigned*)(F.ws + WS_CTL);
        volatile LAS unsigned* qslot = (volatile LAS unsigned*)(F.lds + att::L_LAM + 16);
        for (;;) {
            if (F.tid == 0) *qslot = __hip_atomic_fetch_add(qctr, 1u, __ATOMIC_RELAXED, __HIP_MEMORY_SCOPE_AGENT);
            __syncthreads();
            const unsigned idx = *qslot;
            __syncthreads();
            if (idx >= 512u) break;
            const int bh = (int)(idx & 15u);
            att::attn_unit((LAS char*)F.lds, A, bh >> 2, bh & 3, 31 - (int)(idx >> 4));
        }
    } SEAM(3);
    if (IN(4)) REP(4) {
        pg8::Gemm g{(const pg8::bf16_t*)(F.ws + WS_MIX), (const pg8::bf16_t*)(F.ws + WS_WO), M, DM, DM}; pg8::StaticOrder S; S.init(M, DM, F.G, F.cv, 1);
        pg8::EpiOut E{(const float*)(F.ws + WS_IRS), (pg8::bf16_t*)(F.ws + WS_H1B), (float*)(F.ws + WS_SS1)};
        pg8::gemm_phase<pg8::EpiOut, pg8::StaticOrder, true, true>(F.lds, g, S, E);
    } SEAML(4);
    if (IN(5)) REP(5) {
        LAS float* rtab = (LAS float*)(F.lds + 131072); const int rbase = (F.cv & 7) * 2048;
        { const float* SS1 = (const float*)(F.ws + WS_SS1);
#pragma unroll
          for (int q4 = 0; q4 < 4; ++q4) {
              if (F.G == 256 && q4 > 0) break;
              const int r = F.G == 256 ? (4 * (F.tid >> 8) + ((F.cv >> 3) & 3)) * 256 + (F.tid & 255) : q4 * 512 + F.tid; const f32x4* sp = (const f32x4*)(SS1 + (size_t)(rbase + r) * 32);
              f32x4 t = sp[0];
#pragma unroll
              for (int i = 1; i < 8; ++i) t += sp[i];
              rtab[r] = 1.0f / sqrtf(((t[0] + t[1]) + (t[2] + t[3])) * (1.0f / 2048.0f) + 1e-6f); } }
        __syncthreads();
        pg8::Gemm g{(const pg8::bf16_t*)(F.ws + WS_H1B), (const pg8::bf16_t*)(F.ws + WS_WUP), M, FF, DM}; pg8::StaticOrder S; S.init(M, FF, F.G, F.cv);
        pg8::EpiUp E{(bf16*)(F.ws + WS_HID), rtab, rbase, (const float*)(F.ws + WS_SS1)};
        pg8::gemm_phase<pg8::EpiUp, pg8::StaticOrder, true, true>(F.lds, g, S, E);
    } SEAML(5);
    if (IN(6)) REP(6) {
        pg8::Gemm g{(const pg8::bf16_t*)(F.ws + WS_HID), (const pg8::bf16_t*)(F.ws + WS_WDN), M, DM, FF}; pg8::StaticOrder S; S.init(M, DM, F.G, F.cv, 1);
        pg8::EpiDown E{(pg8::bf16_t*)(F.ws + WS_H1B), (float*)(F.ws + WS_SS2)};
        pg8::gemm_phase<pg8::EpiDown, pg8::StaticOrder, true, true>(F.lds, g, S, E);
    } SEAML(6);
    if (IN(7)) REP(7) { final_norm_phase(F); }
#undef IN
#undef SEAM
}

#ifndef MK_ONE_LAUNCH
#define MK_ONE_LAUNCH 1
#endif
extern "C" void kernel_launch(void* const* d_in, const int* in_sizes, int n_in, void* d_out, int out_size, void* d_ws, size_t ws_size, hipStream_t stream) {
    static int grid = 0;
    if (grid == 0) {
        if (n_in != 18 || in_sizes[0] != M * DM || out_size != M * DM || ws_size < WS_END) { fprintf(stderr, "kernel_launch: unexpected shapes (n_in %d, in0 %d, out %d, ws %zu need %zu)\n", n_in, n_in > 0 ? in_sizes[0] : -1, out_size, ws_size, (size_t)WS_END); grid = -1; return; }
        int dev = 0, cus = 0, per_cu = 0;
        (void)hipGetDevice(&dev); (void)hipDeviceGetAttribute(&cus, hipDeviceAttributeMultiprocessorCount, dev);
        if (hipFuncSetAttribute((const void*)fwd_kernel, hipFuncAttributeMaxDynamicSharedMemorySize, LDS_BYTES) != hipSuccess) { fprintf(stderr, "kernel_launch: hipFuncSetAttribute failed\n"); grid = -1; return; }
        if (hipOccupancyMaxActiveBlocksPerMultiprocessor(&per_cu, (const void*)fwd_kernel, NWAVES * 64, LDS_BYTES) != hipSuccess || per_cu < 1) { fprintf(stderr, "kernel_launch: occupancy query says %d\n", per_cu); per_cu = 1; }
        (void)hipGetLastError();
        grid = cus > 0 ? cus : 256;
    }
    if (grid < 0) return;
    if (hipMemsetAsync((char*)d_ws + WS_CTL, 0, 128 * 1024, stream) != hipSuccess) { fprintf(stderr, "kernel_launch: hipMemsetAsync failed\n"); return; }
    Args a{};
    for (int i = 0; i < 18; ++i) a.in[i] = (const float*)d_in[i];
    a.out = (float*)d_out; a.ws = (unsigned char*)d_ws;
#if MK_ONE_LAUNCH
    a.ph_lo = 0; a.ph_hi = NPHASE;
    void* kargs[] = {&a};
    hipError_t e = hipLaunchCooperativeKernel((const void*)fwd_kernel, dim3(grid), dim3(NWAVES * 64), kargs, LDS_BYTES, stream);
    if (e != hipSuccess) fprintf(stderr, "kernel_launch: cooperative launch failed: %s\n", hipGetErrorString(e));
#else
    for (int p = 0; p < NPHASE; ++p) { a.ph_lo = p; a.ph_hi = p + 1; hipLaunchKernelGGL(fwd_kernel, dim3(grid), dim3(NWAVES * 64), LDS_BYTES, stream, a); }
#endif
}
```

```cpp
#include <hip/hip_runtime.h>
#include <hip/hip_cooperative_groups.h>
#include <cstdio>
#include <cstdint>
namespace cg = cooperative_groups;

namespace pg8 {
#define PG8_LAS __attribute__((address_space(3)))
typedef unsigned short bf16_t;
typedef short bf16x8 __attribute__((ext_vector_type(8)));
typedef float f32x4 __attribute__((ext_vector_type(4)));
typedef unsigned u32x4 __attribute__((ext_vector_type(4)));
constexpr int BM = 256, BK = 64, HALF = 128, HTB = HALF * BK * 2  , STAGE_BYTES = 8 * HTB, NXCD = 8, WGM = 4;

__host__ __device__ __forceinline__ int lds_byte(int r, int c) { const int st = (r >> 4) * 2 + (c >> 5), rr = r & 15, cc = c & 31, ob = rr * 64 + cc * 2; return st * 1024 + (ob ^ (((ob >> 9) & 1) << 5)); }
__host__ __device__ __forceinline__ void stage_rc(int b, int& R, int& C) { const int st = b / 1024, sb = b % 1024, swz = sb ^ (((sb >> 9) & 1) << 5); R = (st >> 1) * 16 + swz / 64; C = (st & 1) * 32 + (swz % 64) / 2; }
__host__ __device__ __forceinline__ int perm32(int rho) { const int n = rho >> 4, i = rho & 15; return 8 * (i >> 2) + 4 * n + (i & 3); }

struct Unit { int pm, pn; };
struct Gemm { const bf16_t* A; const bf16_t* Bt; int M, N, K; };

struct StaticOrder {
    int nM, nN, nwg, G, c, rev;
    __host__ __device__ void init(int M, int N, int G_, int c_, int rev_ = 0) { nM = M / BM; nN = N / BM; nwg = nM * nN; G = G_; c = c_; rev = rev_; }
    __host__ __device__ bool next(int i, Unit& u) const {
        const long L = (long)i * G + c; if (L >= nwg) return false;
        int wgid = (int)L; { const int q = nwg / NXCD, r = nwg % NXCD, xcd = wgid % NXCD, off = wgid / NXCD; wgid = (xcd < r ? xcd * (q + 1) : r * (q + 1) + (xcd - r) * q) + off; }
        const int nig = WGM * nN, gid = (wgid / nig) ^ rev, fm = gid * WGM, gsz = (nM - fm) < WGM ? (nM - fm) : WGM;
        u.pm = fm + ((wgid % nig) % gsz); u.pn = (wgid % nig) / gsz; return true;
    }
    __device__ __forceinline__ void a_ready(const Unit&) const {}
    __device__ __forceinline__ void done(const Unit&) const {}
};

__device__ __forceinline__ unsigned cvt_pk_bf16(float lo, float hi) { unsigned r; asm volatile("v_cvt_pk_bf16_f32 %0, %1, %2" : "=v"(r) : "v"(lo), "v"(hi)); return r; }
typedef float f32x2 __attribute__((ext_vector_type(2)));
typedef unsigned u32x2e __attribute__((ext_vector_type(2)));
__device__ __forceinline__ u32x4 pack8_bf16(const f32x4 a, const f32x4 b) { u32x4 w; w.x = cvt_pk_bf16(a[0], a[1]); w.y = cvt_pk_bf16(a[2], a[3]); w.z = cvt_pk_bf16(b[0], b[1]); w.w = cvt_pk_bf16(b[2], b[3]); return w; }
struct EpiProj {
    static constexpr bool PERM = true, AFTER_DRAIN = false;
    bf16_t* O; int ldc; int q_lo, q_hi; float qscale;
    __device__ __forceinline__ void operator()(const f32x4 (&acc)[2][2][4][2], const Unit& u, int wr, int wc, int fr, int fq) const {
        const int row0 = u.pm * BM + wr * 64 + fr, col0 = u.pn * BM + wc * 32 + 8 * fq;
        const float sc = (u.pn >= q_lo && u.pn < q_hi) ? qscale : 1.f;
#pragma unroll
        for (int ai = 0; ai < 2; ++ai)
#pragma unroll
            for (int m = 0; m < 4; ++m) { bf16_t* rowp = O + (size_t)(row0 + ai * HALF + m * 16) * ldc + col0;
#pragma unroll
                for (int bj = 0; bj < 2; ++bj) *(u32x4*)(rowp + bj * HALF) = pack8_bf16(acc[ai][bj][m][0] * sc, acc[ai][bj][m][1] * sc); }
    }
};
struct EpiOut {
    static constexpr bool PERM = true, AFTER_DRAIN = false;
    const float* IRS; bf16_t* H1B; float* SS;
    __device__ __forceinline__ void operator()(const f32x4 (&acc)[2][2][4][2], const Unit& u, int wr, int wc, int fr, int fq) const {
        const int row0 = u.pm * BM + wr * 64 + fr, col0 = u.pn * BM + wc * 32 + 8 * fq;
        u32x4 xr2[2][4][2]; float irs[2][4];
#pragma unroll
        for (int ai = 0; ai < 2; ++ai)
#pragma unroll
            for (int m = 0; m < 4; ++m) { const int row = row0 + ai * HALF + m * 16; const size_t off = (size_t)row * 2048 + col0; irs[ai][m] = IRS[row];
#pragma unroll
                for (int bj = 0; bj < 2; ++bj) xr2[ai][m][bj] = *(const u32x4*)(H1B + off + bj * HALF); }
        asm volatile("" ::: "memory");
#pragma unroll
        for (int ai = 0; ai < 2; ++ai)
#pragma unroll
            for (int m = 0; m < 4; ++m) { const int row = row0 + ai * HALF + m * 16; const size_t off = (size_t)row * 2048 + col0; float ss = 0.f; const float s = irs[ai][m];
#pragma unroll
                for (int bj = 0; bj < 2; ++bj) { const u32x4 w = xr2[ai][m][bj];
                    const f32x4 r0 = {__uint_as_float(w.x << 16), __uint_as_float(w.x & 0xffff0000u), __uint_as_float(w.y << 16), __uint_as_float(w.y & 0xffff0000u)};
                    const f32x4 r1 = {__uint_as_float(w.z << 16), __uint_as_float(w.z & 0xffff0000u), __uint_as_float(w.w << 16), __uint_as_float(w.w & 0xffff0000u)};
                    const f32x4 h0 = r0 * s + acc[ai][bj][m][0], h1 = r1 * s + acc[ai][bj][m][1];
                    *(u32x4*)(H1B + off + bj * HALF) = pack8_bf16(h0, h1);
                    ss += (h0[0] * h0[0] + h0[1] * h0[1]) + (h0[2] * h0[2] + h0[3] * h0[3]) + (h1[0] * h1[0] + h1[1] * h1[1]) + (h1[2] * h1[2] + h1[3] * h1[3]); }
                ss += __shfl_xor(ss, 16); ss += __shfl_xor(ss, 32);
                if (fq == 0) SS[(size_t)row * 32 + u.pn * 4 + wc] = ss; }
    }
};
struct EpiUp {
    static constexpr bool PERM = true, AFTER_DRAIN = false;
    bf16_t* O; const PG8_LAS float* rstd_tab; int row_base; const float* SS;
    __device__ __forceinline__ void operator()(const f32x4 (&acc)[2][2][4][2], const Unit& u, int wr, int wc, int fr, int fq) const {
        const int row0 = u.pm * BM + wr * 64 + fr, col0 = u.pn * BM + wc * 32 + 8 * fq;
#pragma unroll
        for (int ai = 0; ai < 2; ++ai)
#pragma unroll
            for (int m = 0; m < 4; ++m) { const int row = row0 + ai * HALF + m * 16;
                float rstd;
                if ((unsigned)(row - row_base) < 2048u) rstd = rstd_tab[row - row_base];
                else { const f32x4* sp = (const f32x4*)(SS + (size_t)row * 32); f32x4 t = sp[0];
#pragma unroll
                    for (int i = 1; i < 8; ++i) t += sp[i];
                    rstd = 1.0f / sqrtf(((t[0] + t[1]) + (t[2] + t[3])) * (1.0f / 2048.0f) + 1e-6f); }
                bf16_t* rowp = O + (size_t)row * 8192 + col0;
#pragma unroll
                for (int bj = 0; bj < 2; ++bj) { f32x4 v0 = acc[ai][bj][m][0] * rstd, v1 = acc[ai][bj][m][1] * rstd;
#pragma unroll
                    for (int e = 0; e < 4; ++e) { v0[e] = fmaxf(v0[e], 0.f); v0[e] *= v0[e]; v1[e] = fmaxf(v1[e], 0.f); v1[e] *= v1[e]; }
                    *(u32x4*)(rowp + bj * HALF) = pack8_bf16(v0, v1); } }
    }
};
struct EpiDown {
    static constexpr bool PERM = true, AFTER_DRAIN = false;
    bf16_t* HB; float* SS;
    __device__ __forceinline__ void operator()(const f32x4 (&acc)[2][2][4][2], const Unit& u, int wr, int wc, int fr, int fq) const {
        const int row0 = u.pm * BM + wr * 64 + fr, col0 = u.pn * BM + wc * 32 + 8 * fq;
#pragma unroll
        for (int ai = 0; ai < 2; ++ai) {
            u32x4 xr[4][2];
#pragma unroll
            for (int m = 0; m < 4; ++m) { const size_t off = (size_t)(row0 + ai * HALF + m * 16) * 2048 + col0;
#pragma unroll
                for (int bj = 0; bj < 2; ++bj) xr[m][bj] = *(const u32x4*)(HB + off + bj * HALF); }
            asm volatile("" ::: "memory");
#pragma unroll
            for (int m = 0; m < 4; ++m) { const int row = row0 + ai * HALF + m * 16; const size_t off = (size_t)row * 2048 + col0; float ss = 0.f;
#pragma unroll
                for (int bj = 0; bj < 2; ++bj) { const u32x4 w = xr[m][bj];
                    const f32x4 r0 = {__uint_as_float(w.x << 16), __uint_as_float(w.x & 0xffff0000u), __uint_as_float(w.y << 16), __uint_as_float(w.y & 0xffff0000u)};
                    const f32x4 r1 = {__uint_as_float(w.z << 16), __uint_as_float(w.z & 0xffff0000u), __uint_as_float(w.w << 16), __uint_as_float(w.w & 0xffff0000u)};
                    const f32x4 h0 = r0 + acc[ai][bj][m][0], h1 = r1 + acc[ai][bj][m][1];
                    *(u32x4*)(HB + off + bj * HALF) = pack8_bf16(h0, h1);
                    ss += (h0[0] * h0[0] + h0[1] * h0[1]) + (h0[2] * h0[2] + h0[3] * h0[3]) + (h1[0] * h1[0] + h1[1] * h1[1]) + (h1[2] * h1[2] + h1[3] * h1[3]); }
                ss += __shfl_xor(ss, 16); ss += __shfl_xor(ss, 32);
                if (fq == 0) SS[(size_t)row * 32 + u.pn * 4 + wc] = ss; }
        }
    }
};
template <class Epi, class Sched, bool ALIGN_EPI = false, bool SP2 = false>
__device__ __forceinline__ void gemm_phase(PG8_LAS unsigned char* lds, const Gemm g, const Sched& S, const Epi& E) {
    const int tid = threadIdx.x, wid = __builtin_amdgcn_readfirstlane(tid >> 6), lane = tid & 63, wr = wid >> 2, wc = wid & 3, fr = lane & 15, fq = lane >> 4;
    const int K = g.K, nt = K / BK;
    unsigned voffA[2], voffB[2];
#pragma unroll
    for (int i = 0; i < 2; ++i) { int R, C; stage_rc(tid * 16 + i * 8192, R, C); const int Rb = Epi::PERM ? ((R & ~31) + perm32(R & 31)) : R;
        voffA[i] = (unsigned)(R * K + C) * 2u; voffB[i] = (unsigned)(Rb * K + C) * 2u; }
    const size_t kstep = (size_t)(BK * 2);
    const size_t hstep = (size_t)HALF * K * 2;
    const size_t tstep = 2 * hstep;
    const unsigned ldsw = (unsigned)wid * 1024u;
    const int aoff = lds_byte(wr * 64 + fr, fq * 8), boff = lds_byte(wc * 32 + fr, fq * 8);
#define PG8_SA(b, h) (((b) * 2 + (h)) * HTB)
#define PG8_SB(b, h) ((4 + (b) * 2 + (h)) * HTB)
#define PG8_STAGE(bufoff, gbase, voff) do { _Pragma("unroll") for (int _i = 0; _i < 2; ++_i) \
        __builtin_amdgcn_global_load_lds((const unsigned*)((const char*)(gbase) + (voff)[_i]), (PG8_LAS unsigned*)(lds + (bufoff) + ldsw + _i * 8192), 16, 0, 0); } while (0)
#define PG8_LDA(dst, b, h) do { _Pragma("unroll") for (int m = 0; m < 4; ++m) _Pragma("unroll") for (int k = 0; k < 2; ++k) dst[m][k] = *(const PG8_LAS bf16x8*)(lds + PG8_SA(b, h) + aoff + m * 2048 + k * 1024); } while (0)
#define PG8_LDB(dst, b, h) do { _Pragma("unroll") for (int n = 0; n < 2; ++n) _Pragma("unroll") for (int k = 0; k < 2; ++k) dst[n][k] = *(const PG8_LAS bf16x8*)(lds + PG8_SB(b, h) + boff + n * 2048 + k * 1024); } while (0)
#define PG8_MMA(ai, bj, At, Bt) do { __builtin_amdgcn_s_setprio(1); _Pragma("unroll") for (int m = 0; m < 4; ++m) _Pragma("unroll") for (int n = 0; n < 2; ++n) _Pragma("unroll") for (int k = 0; k < 2; ++k) \
        acc[ai][bj][m][n] = __builtin_amdgcn_mfma_f32_16x16x32_bf16(Bt[n][k], At[m][k], acc[ai][bj][m][n], 0, 0, 0); __builtin_amdgcn_s_setprio(0); } while (0)
#define PG8_WAIT_V(n) asm volatile("s_waitcnt vmcnt(" #n ")" ::: "memory")
#define PG8_WAIT_L(n) asm volatile("s_waitcnt lgkmcnt(" #n ")" ::: "memory")
#define PG8_BAR __builtin_amdgcn_s_barrier()
#define PG8_SCHED __builtin_amdgcn_sched_barrier(0)
    Unit cur, nxt; int ui = 0;
    if (!S.next(0, cur)) return;
    f32x4 acc[2][2][4][2];
#pragma unroll
    for (int a = 0; a < 2; ++a)
#pragma unroll
        for (int b = 0; b < 2; ++b)
#pragma unroll
            for (int m = 0; m < 4; ++m)
#pragma unroll
                for (int n = 0; n < 2; ++n) acc[a][b][m][n] = (f32x4){0.f, 0.f, 0.f, 0.f};
    bf16x8 At[4][2], B0[2][2], B1[2][2];
    const char* cA = (const char*)g.A + (size_t)cur.pm * tstep; const char* cB = (const char*)g.Bt + (size_t)cur.pn * tstep;
    S.a_ready(cur);
    if constexpr (SP2) {
        PG8_STAGE(PG8_SB(0, 0), cB, voffB); PG8_STAGE(PG8_SB(0, 1), cB + hstep, voffB); PG8_STAGE(PG8_SA(0, 0), cA, voffA); PG8_STAGE(PG8_SA(0, 1), cA + hstep, voffA);
        if (wr == 1) PG8_BAR;
        PG8_WAIT_V(2); PG8_BAR;
        PG8_STAGE(PG8_SB(1, 0), cB + kstep, voffB); PG8_STAGE(PG8_SA(1, 0), cA + kstep, voffA); PG8_STAGE(PG8_SB(1, 1), cB + hstep + kstep, voffB);
        PG8_WAIT_V(6); PG8_BAR;
    } else {
        PG8_STAGE(PG8_SB(0, 0), cB, voffB); PG8_STAGE(PG8_SA(0, 0), cA, voffA); PG8_STAGE(PG8_SB(0, 1), cB + hstep, voffB); PG8_STAGE(PG8_SA(0, 1), cA + hstep, voffA);
        if (wr == 1) PG8_BAR;
        PG8_WAIT_V(4); PG8_BAR;
        PG8_STAGE(PG8_SB(1, 0), cB + kstep, voffB); PG8_STAGE(PG8_SA(1, 0), cA + kstep, voffA); PG8_STAGE(PG8_SB(1, 1), cB + hstep + kstep, voffB);
        PG8_WAIT_V(6); PG8_BAR;
    }
    for (;;) {
        const bool has_next = S.next(ui + 1, nxt);
        const char* nA = has_next ? (const char*)g.A + (size_t)nxt.pm * tstep : cA; const char* nB = has_next ? (const char*)g.Bt + (size_t)nxt.pn * tstep : cB;
        for (int t = 0; t < nt; t += 2) {
            const bool last = (t == nt - 2);
            const char* a1 = cA + (size_t)(t + 1) * kstep;
            const char* a2 = last ? nA : cA + (size_t)(t + 2) * kstep; const char* b2 = last ? nB : cB + (size_t)(t + 2) * kstep;
            const char* a3 = a2 + kstep; const char* b3 = b2 + kstep;
            if (last && has_next) S.a_ready(nxt);
            if constexpr (SP2) {
            PG8_LDB(B0, 0, 0); PG8_LDB(B1, 0, 1); PG8_SCHED; PG8_LDA(At, 0, 0); PG8_STAGE(PG8_SA(1, 1), a1 + hstep, voffA);
            PG8_WAIT_V(8); PG8_WAIT_L(0); PG8_BAR; PG8_MMA(0, 0, At, B0); PG8_MMA(0, 1, At, B1); PG8_BAR; PG8_SCHED;
            PG8_LDA(At, 0, 1); PG8_STAGE(PG8_SB(0, 0), b2, voffB); PG8_STAGE(PG8_SB(0, 1), b2 + hstep, voffB); PG8_STAGE(PG8_SA(0, 0), a2, voffA);
            PG8_WAIT_V(8); PG8_WAIT_L(0); PG8_BAR; PG8_MMA(1, 0, At, B0); PG8_MMA(1, 1, At, B1); PG8_BAR; PG8_SCHED;
            PG8_LDB(B0, 1, 0); PG8_LDB(B1, 1, 1); PG8_SCHED; PG8_LDA(At, 1, 0); PG8_STAGE(PG8_SA(0, 1), a2 + hstep, voffA);
            PG8_WAIT_V(8); PG8_WAIT_L(0); PG8_BAR; PG8_MMA(0, 0, At, B0); PG8_MMA(0, 1, At, B1); PG8_BAR; PG8_SCHED;
            PG8_LDA(At, 1, 1); PG8_STAGE(PG8_SB(1, 0), b3, voffB); PG8_STAGE(PG8_SB(1, 1), b3 + hstep, voffB); PG8_STAGE(PG8_SA(1, 0), a3, voffA);
            PG8_WAIT_V(8); PG8_WAIT_L(0); PG8_BAR; PG8_MMA(1, 0, At, B0); PG8_MMA(1, 1, At, B1); PG8_BAR; PG8_SCHED;
            } else {
            PG8_LDB(B0, 0, 0); PG8_SCHED; PG8_LDA(At, 0, 0); PG8_STAGE(PG8_SA(1, 1), a1 + hstep, voffA);
            PG8_WAIT_L(8); PG8_BAR; PG8_WAIT_L(0); PG8_MMA(0, 0, At, B0); PG8_BAR; PG8_SCHED;
            PG8_LDB(B1, 0, 1); PG8_STAGE(PG8_SB(0, 0), b2, voffB);
            PG8_BAR; PG8_WAIT_L(0); PG8_MMA(0, 1, At, B1); PG8_BAR;
            PG8_LDA(At, 0, 1); PG8_STAGE(PG8_SA(0, 0), a2, voffA);
            PG8_BAR; PG8_WAIT_L(0); PG8_MMA(1, 0, At, B0); PG8_BAR; PG8_SCHED;
            PG8_STAGE(PG8_SB(0, 1), b2 + hstep, voffB);
            PG8_WAIT_V(6); PG8_BAR; PG8_MMA(1, 1, At, B1); PG8_BAR;
            PG8_LDB(B0, 1, 0); PG8_SCHED; PG8_LDA(At, 1, 0); PG8_STAGE(PG8_SA(0, 1), a2 + hstep, voffA);
            PG8_WAIT_L(8); PG8_BAR; PG8_WAIT_L(0); PG8_MMA(0, 0, At, B0); PG8_BAR; PG8_SCHED;
            PG8_LDB(B1, 1, 1); PG8_STAGE(PG8_SB(1, 0), b3, voffB);
            PG8_BAR; PG8_WAIT_L(0); PG8_MMA(0, 1, At, B1); PG8_BAR;
            PG8_LDA(At, 1, 1); PG8_STAGE(PG8_SA(1, 0), a3, voffA);
            PG8_BAR; PG8_WAIT_L(0); PG8_MMA(1, 0, At, B0); PG8_BAR; PG8_SCHED;
            PG8_STAGE(PG8_SB(1, 1), b3 + hstep, voffB);
            PG8_WAIT_V(6); PG8_BAR; PG8_MMA(1, 1, At, B1); PG8_BAR;
            }
        }
        if constexpr (ALIGN_EPI) { if (wr == 0) PG8_BAR; }
        if constexpr (!Epi::AFTER_DRAIN) { E(acc, cur, wr, wc, fr, fq); S.done(cur); }
        if (!has_next) break;
#pragma unroll
        for (int a = 0; a < 2; ++a)
#pragma unroll
            for (int b = 0; b < 2; ++b)
#pragma unroll
                for (int m = 0; m < 4; ++m)
#pragma unroll
                    for (int n = 0; n < 2; ++n) acc[a][b][m][n] = (f32x4){0.f, 0.f, 0.f, 0.f};
        cur = nxt; cA = nA; cB = nB; ++ui;
        if constexpr (ALIGN_EPI) { if (wr == 1) PG8_BAR; }
    }
    PG8_WAIT_V(0);
    if constexpr (!ALIGN_EPI) { if (wr == 0) PG8_BAR; }
    PG8_BAR;
    if constexpr (Epi::AFTER_DRAIN) { E.fused(acc, cur, wr, wc, fr, fq, lds, wid, lane); S.done(cur); }
#undef PG8_SA
#undef PG8_SB
#undef PG8_STAGE
#undef PG8_LDA
#undef PG8_LDB
#undef PG8_MMA
#undef PG8_WAIT_V
#undef PG8_WAIT_L
#undef PG8_BAR
#undef PG8_SCHED
}
}
namespace att {
#define ALAS __attribute__((address_space(3)))
typedef short bf16x8 __attribute__((ext_vector_type(8)));
typedef short s16x4 __attribute__((ext_vector_type(4)));
typedef float f32x16 __attribute__((ext_vector_type(16)));
typedef float f32x4 __attribute__((ext_vector_type(4)));
typedef unsigned u32x4 __attribute__((ext_vector_type(4)));
typedef unsigned short bf16_t;
constexpr int SEQ = 4096, PITCH = 7168, QCOL = 4096, KCOL = 5120, VCOL = 6144, MIXP = 2048;
constexpr int QBLK = 32, KVBLK = 64, QB = 128;
constexpr int TILE_B = 16384;
constexpr int L_WS = 0, L_BIAS = 2048, L_LAM = 6144, L_DFN = 7168, L_TILES = 8192;
constexpr int L_VLO = L_TILES, L_VHI = L_TILES + 2 * TILE_B, L_K1 = L_TILES + 4 * TILE_B, L_K2 = L_TILES + 6 * TILE_B;
constexpr int XROW = 260;
constexpr int LDS_END = L_TILES + 4 * 32 * XROW * 4;
constexpr float LOG2E = 1.4426950408889634f;
constexpr float QSCALE = 0.08838834764831845f * 1.4426950408889634f;

#define KSWZ(row, colB) ((row) * 256 + ((colB) ^ (((row) & 15) << 4)))
#define SBAR() __builtin_amdgcn_sched_barrier(0)
__device__ __forceinline__ int v_st(int k, int c) { const int kk = (k & ~0xC) | ((k & 4) << 1) | ((k & 8) >> 1); return ((kk >> 3) * 4 + (c >> 5)) * 512 + ((kk & 7) * 32 + (c & 31)) * 2; }
__device__ __forceinline__ int v_rd_base(int lane) { return ((lane & 3) << 3) | (((lane >> 2) & 3) << 6) | (((lane >> 4) & 1) << 5) | (((lane >> 5) & 1) << 8); }
constexpr int v_rd_off(int d0, int ks, int half) { return d0 * 512 + ks * 4096 + half * 2048; }
__device__ __forceinline__ int crow(int r, int hi) { return (r & 3) + 8 * (r >> 2) + 4 * hi; }
__device__ __forceinline__ unsigned cvtpk(float lo, float hi) { unsigned r; asm volatile("v_cvt_pk_bf16_f32 %0, %1, %2" : "=v"(r) : "v"(lo), "v"(hi)); return r; }

__device__ __forceinline__ void qkt(f32x16& p0, f32x16& p1, const ALAS char* kt, int r32, int hi, const bf16x8* qr) {
    p0 = f32x16{}; p1 = f32x16{};
    const ALAS char* kb[4];
#pragma unroll
    for (int dd = 0; dd < 4; ++dd) kb[dd] = kt + KSWZ(r32, (dd * 16 + hi * 8) * 2);
#pragma unroll
    for (int d0 = 0; d0 < 8; ++d0) { const ALAS char* a = kb[d0 & 3] + (d0 >> 2) * 128;
        const bf16x8 b0 = *(const ALAS bf16x8*)a;
        const bf16x8 b1 = *(const ALAS bf16x8*)(a + 32 * 256);
        p0 = __builtin_amdgcn_mfma_f32_32x32x16_bf16(b0, qr[d0], p0, 0, 0, 0);
        p1 = __builtin_amdgcn_mfma_f32_32x32x16_bf16(b1, qr[d0], p1, 0, 0, 0); }
}
__device__ __forceinline__ void pv_tile(f32x16* o, unsigned vb, bf16x8 pa0, bf16x8 pa1, bf16x8 pa2, bf16x8 pa3) {
#define TRRD(dst, off) asm volatile("ds_read_b64_tr_b16 %0, %1 offset:%2" : "=&v"(dst) : "v"(vb), "i"(off) : "memory")
#define PV_D0(d0) do { s16x4 l0, l1, l2, l3, h0, h1, h2, h3; constexpr int b_ = v_rd_off(d0, 0, 0); \
        TRRD(l0, b_); TRRD(h0, b_ + 2048); TRRD(l1, b_ + 4096); TRRD(h1, b_ + 6144); TRRD(l2, b_ + 8192); TRRD(h2, b_ + 10240); TRRD(l3, b_ + 12288); TRRD(h3, b_ + 14336); \
        asm volatile("s_waitcnt lgkmcnt(0)" ::: "memory"); SBAR(); \
        o[d0] = __builtin_amdgcn_mfma_f32_32x32x16_bf16(pa0, (bf16x8){l0[0], l0[1], l0[2], l0[3], h0[0], h0[1], h0[2], h0[3]}, o[d0], 0, 0, 0); \
        o[d0] = __builtin_amdgcn_mfma_f32_32x32x16_bf16(pa1, (bf16x8){l1[0], l1[1], l1[2], l1[3], h1[0], h1[1], h1[2], h1[3]}, o[d0], 0, 0, 0); \
        o[d0] = __builtin_amdgcn_mfma_f32_32x32x16_bf16(pa2, (bf16x8){l2[0], l2[1], l2[2], l2[3], h2[0], h2[1], h2[2], h2[3]}, o[d0], 0, 0, 0); \
        o[d0] = __builtin_amdgcn_mfma_f32_32x32x16_bf16(pa3, (bf16x8){l3[0], l3[1], l3[2], l3[3], h3[0], h3[1], h3[2], h3[3]}, o[d0], 0, 0, 0); } while (0)
    PV_D0(0); PV_D0(1); PV_D0(2); PV_D0(3);
#undef PV_D0
#undef TRRD
}

struct AttnArgs { const bf16_t* PROJ; bf16_t* MIX; const float* df_norm; const float* rel_bias; const float* lq1; const float* lk1; const float* lq2; const float* lk2; };

__device__ __forceinline__ void attn_setup(ALAS char* lds, const AttnArgs& A) {
    const int tid = threadIdx.x;
    ALAS float* bt = (ALAS float*)(lds + L_BIAS);
    for (int i = tid; i < 1024; i += 512) { const int h = i >> 8, d = (i & 255) - 64;
      float v = -__builtin_inff();
      if (d >= 0) { int bucket = d;
          if (d >= 16) { const int lg = 16 + (int)(log((double)d / 16.0) / log(8.0) * 16.0); bucket = lg < 31 ? lg : 31; }
          v = (A.rel_bias[bucket * 4 + h] - A.rel_bias[31 * 4 + h]) * LOG2E; }
      bt[i] = v; }
    if (tid >= 256) ((ALAS float*)(lds + L_DFN))[tid - 256] = A.df_norm[tid - 256];
    if (tid < 64) {
        float s1 = A.lq1[tid] * A.lk1[tid] + A.lq1[tid + 64] * A.lk1[tid + 64], s2 = A.lq2[tid] * A.lk2[tid] + A.lq2[tid + 64] * A.lk2[tid + 64];
#pragma unroll
        for (int o = 1; o < 64; o <<= 1) { s1 += __shfl_xor(s1, o); s2 += __shfl_xor(s2, o); }
        if (tid == 0) *(ALAS float*)(lds + L_LAM) = expf(s1) - expf(s2) + 0.2f;
    }
    __syncthreads();
}

__device__ __forceinline__ void attn_unit(ALAS char* lds, const AttnArgs& A, int b, int h, int qb) {
    const int tid = threadIdx.x, wid = __builtin_amdgcn_readfirstlane(tid >> 6), lane = tid & 63, r32 = lane & 31, hi = lane >> 5;
    const int map = wid >> 2, qs = wid & 3;
    const int q0 = qb * QB, R0 = q0 + qs * QBLK;
    const int NT = 2 * qb + 2;
    const size_t rowbase = (size_t)b * SEQ;
    ALAS float* wsf = (ALAS float*)(lds + L_WS) + wid * 64;
    const ALAS float* bt = (const ALAS float*)(lds + L_BIAS) + h * 256;
    const __amdgpu_buffer_rsrc_t rsrc = __builtin_amdgcn_make_buffer_rsrc((void*)A.PROJ, 0, 0x7fffffff, 0x00020000);
    const unsigned voffK = (unsigned)(((lane >> 4) * PITCH + (((lane & 15) ^ (4 * (wid & 3) + (lane >> 4))) * 8)) * 2);
    const int t3 = (lane & 31) >> 2;
    const unsigned voffV = (unsigned)(((8 * ((t3 >> 2) & 1) + (t3 & 3)) * PITCH + 32 * (lane >> 5) + 8 * (lane & 3)) * 2);
    const unsigned soK = (unsigned)(((rowbase + 4 * wid) * PITCH + KCOL + h * 256) * 2);
    const unsigned soV = (unsigned)(((rowbase + 16 * (wid >> 2) + 4 * ((wid >> 1) & 1)) * PITCH + VCOL + h * 256 + 64 * (wid & 1)) * 2);
#define DMA16(ldsoff, voff, soff) __builtin_amdgcn_raw_ptr_buffer_load_lds(rsrc, (ALAS void*)(lds + (ldsoff)), 16, (voff), (soff), 0, 0)
#define ATT_DMA(st_, g_) do { const unsigned tk_ = soK + (unsigned)(st_) * (32 * PITCH * 2), tv_ = soV + (unsigned)(st_) * (32 * PITCH * 2); const int pw_ = (g_) * 8192 + wid * 1024; \
        DMA16(L_K1 + pw_, voffK, tk_); DMA16(L_K2 + pw_, voffK, tk_ + 256); DMA16(L_VLO + pw_, voffV, tv_); DMA16(L_VHI + pw_, voffV, tv_ + 256); } while (0)
#define ATT_DMA_K(st_, g_) do { const unsigned tk_ = soK + (unsigned)(st_) * (32 * PITCH * 2); const int pw_ = (g_) * 8192 + wid * 1024; DMA16(L_K1 + pw_, voffK, tk_); DMA16(L_K2 + pw_, voffK, tk_ + 256); } while (0)
#define ATT_DMA_V(st_, g_) do { const unsigned tv_ = soV + (unsigned)(st_) * (32 * PITCH * 2); const int pw_ = (g_) * 8192 + wid * 1024; DMA16(L_VLO + pw_, voffV, tv_); DMA16(L_VHI + pw_, voffV, tv_ + 256); } while (0)
    bf16x8 qr[8];
    { const bf16_t* qp = A.PROJ + (rowbase + R0 + r32) * PITCH + QCOL + h * 256 + map * 128 + hi * 8;
#pragma unroll
      for (int d0 = 0; d0 < 8; ++d0) qr[d0] = *(const bf16x8*)(qp + d0 * 16); }
    const int NS = 4 * qb + 4;
    ATT_DMA(0, 0); ATT_DMA(1, 1);
    asm volatile("s_waitcnt vmcnt(0)" ::: "memory"); __builtin_amdgcn_s_barrier();
    float m_reg = -1e30f, l_reg = 0.f; f32x16 o[8];
#pragma unroll
    for (int i = 0; i < 8; ++i) o[i] = f32x16{};
    const unsigned vrb_lo = (unsigned)(uintptr_t)(lds) + (unsigned)(L_VLO + v_rd_base(lane)), vrb_hi = vrb_lo + (unsigned)(L_VHI - L_VLO);
    const int qpos = R0 + r32;
#define PK4(P, B_, OUT) do { unsigned a0 = cvtpk(P[B_+0], P[B_+1]), a1 = cvtpk(P[B_+2], P[B_+3]); \
        unsigned b0 = cvtpk(P[B_+4], P[B_+5]), b1 = cvtpk(P[B_+6], P[B_+7]); \
        auto r0 = __builtin_amdgcn_permlane32_swap(a0, b0, false, false); auto r1 = __builtin_amdgcn_permlane32_swap(a1, b1, false, false); \
        u32x4 w = {r0[0], r1[0], r0[1], r1[1]}; OUT = *reinterpret_cast<bf16x8*>(&w); } while (0)
#define TRRD(dst, base, off) asm volatile("ds_read_b64_tr_b16 %0, %1 offset:%2" : "=&v"(dst) : "v"(base), "i"(off) : "memory")
    constexpr float RESC_THR = 8.0f;
    f32x16 p_; float mn_ = 0.f, alpha_ = 1.f; bf16x8 pa0 = bf16x8{}, pa1 = bf16x8{};
#define ATT_H1(kbase, cur, hf) do { \
        p_ = f32x16{}; \
        if (R0 - (kbase) < 144) { const ALAS float* tb_ = bt + (qpos - (kbase) - 4 * hi + 64 - 27); \
            _Pragma("unroll") for (int r = 0; r < 16; ++r) p_[r] = tb_[27 - ((r & 3) + 8 * (r >> 2))]; } \
        __builtin_amdgcn_s_setprio(1); \
        int kd_; asm volatile("v_mov_b32 %0, %1" : "=v"(kd_) : "v"(kdel));     \
        _Pragma("unroll") for (int d0 = 0; d0 < 8; ++d0) { \
            const bf16x8 kf = *(const ALAS bf16x8*)((d0 < 4 ? kfb[d0 & 3] : kfb[d0 & 3] + kd_) + ((cur) * TILE_B + (hf) * 8192)); \
            p_ = __builtin_amdgcn_mfma_f32_32x32x16_bf16(kf, qr[d0], p_, 0, 0, 0); } \
        __builtin_amdgcn_s_setprio(0); \
        float pmax = fmaxf(p_[0], p_[1]); \
        _Pragma("unroll") for (int r = 2; r < 16; ++r) pmax = fmaxf(pmax, p_[r]); \
        { auto rr = __builtin_amdgcn_permlane32_swap(__float_as_uint(pmax), __float_as_uint(pmax), false, false); \
          pmax = fmaxf(__uint_as_float(rr[0]), __uint_as_float(rr[1])); } \
        mn_ = (pmax > m_reg + RESC_THR) ? pmax : m_reg; alpha_ = __builtin_amdgcn_exp2f(m_reg - mn_); m_reg = mn_; } while (0)
#define ATT_H2() do { \
        float ps = 0.f; \
        _Pragma("unroll") for (int r = 0; r < 16; ++r) { p_[r] = __builtin_amdgcn_exp2f(p_[r] - mn_); ps += p_[r]; } \
        { auto rr = __builtin_amdgcn_permlane32_swap(__float_as_uint(ps), __float_as_uint(ps), false, false); \
          ps = __uint_as_float(rr[0]) + __uint_as_float(rr[1]); } \
        l_reg = l_reg * alpha_ + ps; \
        if (__any(alpha_ < 1.f)) { if (hi == 0) wsf[r32] = alpha_; asm volatile("s_waitcnt lgkmcnt(0)" ::: "memory"); \
            _Pragma("unroll") for (int r = 0; r < 16; ++r) { const float a_ = wsf[crow(r, hi)]; \
                _Pragma("unroll") for (int d_ = 0; d_ < 8; ++d_) o[d_][r] *= a_; } } \
        PK4(p_, 0, pa0); PK4(p_, 8, pa1); } while (0)
#define ATT_H3(cur, hf) do { \
        s16x4 la0, ha0, la1, ha1, lb0, hb0, lb1, hb1; __builtin_amdgcn_s_setprio(1); \
        { const int b_ = (cur) * TILE_B + (hf) * 8192; TRRD(la0, vrb_lo, b_); TRRD(ha0, vrb_lo, b_ + 2048); TRRD(la1, vrb_lo, b_ + 4096); TRRD(ha1, vrb_lo, b_ + 6144); } \
        _Pragma("unroll") for (int d_ = 0; d_ < 8; d_ += 2) { \
            { const int b_ = (cur) * TILE_B + (hf) * 8192 + ((d_ + 1) & 3) * 512; const unsigned vb_ = ((d_ + 1) >> 2) ? vrb_hi : vrb_lo; \
              TRRD(lb0, vb_, b_); TRRD(hb0, vb_, b_ + 2048); TRRD(lb1, vb_, b_ + 4096); TRRD(hb1, vb_, b_ + 6144); } \
            asm volatile("s_waitcnt lgkmcnt(4)" ::: "memory"); SBAR(); \
            o[d_] = __builtin_amdgcn_mfma_f32_32x32x16_bf16(pa0, (bf16x8){la0[0], la0[1], la0[2], la0[3], ha0[0], ha0[1], ha0[2], ha0[3]}, o[d_], 0, 0, 0); \
            o[d_] = __builtin_amdgcn_mfma_f32_32x32x16_bf16(pa1, (bf16x8){la1[0], la1[1], la1[2], la1[3], ha1[0], ha1[1], ha1[2], ha1[3]}, o[d_], 0, 0, 0); SBAR(); \
            if (d_ + 2 < 8) { const int b_ = (cur) * TILE_B + (hf) * 8192 + ((d_ + 2) & 3) * 512; const unsigned vb_ = ((d_ + 2) >> 2) ? vrb_hi : vrb_lo; \
              TRRD(la0, vb_, b_); TRRD(ha0, vb_, b_ + 2048); TRRD(la1, vb_, b_ + 4096); TRRD(ha1, vb_, b_ + 6144); \
              asm volatile("s_waitcnt lgkmcnt(4)" ::: "memory"); } else { asm volatile("s_waitcnt lgkmcnt(0)" ::: "memory"); } \
            SBAR(); \
            o[d_ + 1] = __builtin_amdgcn_mfma_f32_32x32x16_bf16(pa0, (bf16x8){lb0[0], lb0[1], lb0[2], lb0[3], hb0[0], hb0[1], hb0[2], hb0[3]}, o[d_ + 1], 0, 0, 0); \
            o[d_ + 1] = __builtin_amdgcn_mfma_f32_32x32x16_bf16(pa1, (bf16x8){lb1[0], lb1[1], lb1[2], lb1[3], hb1[0], hb1[1], hb1[2], hb1[3]}, o[d_ + 1], 0, 0, 0); SBAR(); } \
        __builtin_amdgcn_s_setprio(0); \
    } while (0)
    const ALAS char* kfb[4];
#pragma unroll
    for (int dd = 0; dd < 4; ++dd) kfb[dd] = lds + (map ? L_K2 : L_K1) + KSWZ(r32, (dd * 16 + hi * 8) * 2);
    const int kdel = (r32 & 8) ? -128 : 128;
#define ATT_PAIR(st_, cur) do { const int k0a = (st_) * 32, k0b = k0a + 32; const bool acta_ = k0a <= R0 + QBLK - 1, actb_ = k0b <= R0 + QBLK - 1; \
        const int nxa_ = (st_) + 2 < NS ? (st_) + 2 : NS - 1, nxb_ = (st_) + 3 < NS ? (st_) + 3 : NS - 1; constexpr int ga_ = ((cur) ^ 1) * 2, gb_ = ((cur) ^ 1) * 2 + 1;     \
        if (acta_) { SBAR(); ATT_H1(k0a, cur, 0); SBAR(); } \
        ATT_DMA_K(nxa_, ga_); ATT_DMA_K(nxb_, gb_); \
        if (acta_) { SBAR(); ATT_H2(); SBAR(); } \
        ATT_DMA_V(nxa_, ga_); ATT_DMA_V(nxb_, gb_); \
        if (acta_) { SBAR(); ATT_H3(cur, 0); SBAR(); } \
        if (actb_) { SBAR(); ATT_H1(k0b, cur, 1); SBAR(); ATT_H2(); SBAR(); ATT_H3(cur, 1); } \
        asm volatile("s_waitcnt vmcnt(0) lgkmcnt(0)" ::: "memory"); __builtin_amdgcn_s_barrier(); } while (0)
    for (int st = 0; st < NS; st += 4) { ATT_PAIR(st, 0); ATT_PAIR(st + 2, 1); }
#undef ATT_PAIR
#undef ATT_H1
#undef ATT_H2
#undef ATT_H3
#undef ATT_DMA
#undef ATT_DMA_K
#undef ATT_DMA_V
#undef DMA16
#undef TRRD
#undef PK4

    if (hi == 0) wsf[r32] = l_reg; asm volatile("s_waitcnt lgkmcnt(0)" ::: "memory");
    float rli[16];
#pragma unroll
    for (int r = 0; r < 16; ++r) rli[r] = 1.0f / wsf[crow(r, hi)];
    ALAS float* X = (ALAS float*)(lds + L_TILES) + qs * (32 * XROW);
    if (map == 1) {
#pragma unroll
        for (int d_ = 0; d_ < 8; ++d_) {
#pragma unroll
            for (int r = 0; r < 16; ++r) X[crow(r, hi) * XROW + d_ * 32 + r32] = o[d_][r] * rli[r];
            asm volatile("" ::: "memory"); }
    }
    __syncthreads();
    if (map == 0) {
        const float lam = *(const ALAS float*)(lds + L_LAM);
#pragma unroll
        for (int d_ = 0; d_ < 8; ++d_) {
#pragma unroll
            for (int r = 0; r < 16; ++r) { ALAS float* xp = X + crow(r, hi) * XROW + d_ * 32 + r32; *xp = o[d_][r] * rli[r] - lam * *xp; }
            asm volatile("" ::: "memory"); }
        asm volatile("s_waitcnt lgkmcnt(0)" ::: "memory");
        const int row = lane >> 1, half = lane & 1;
        const ALAS f32x4* xr = (const ALAS f32x4*)(X + row * XROW + half * 128);
        float ss = 0.f;
#pragma unroll 8
        for (int i = 0; i < 32; ++i) { const f32x4 v = xr[i]; ss += (v[0] * v[0] + v[1] * v[1]) + (v[2] * v[2] + v[3] * v[3]); }
        ss += __shfl_xor(ss, 1);
        const float rs = 0.8f / sqrtf(ss * (1.0f / 256.0f) + 1e-5f);
        bf16_t* op = A.MIX + (rowbase + R0 + row) * MIXP + 1024 + h * 256 + half * 128;
        const ALAS float* gn = (const ALAS float*)(lds + L_DFN) + half * 128;
#pragma unroll 4
        for (int i = 0; i < 16; ++i) { const f32x4 v0 = xr[2 * i], v1 = xr[2 * i + 1]; const f32x4 g0 = *(const ALAS f32x4*)(gn + 8 * i), g1 = *(const ALAS f32x4*)(gn + 8 * i + 4);
            u32x4 w; w.x = cvtpk(v0[0] * rs * g0[0], v0[1] * rs * g0[1]); w.y = cvtpk(v0[2] * rs * g0[2], v0[3] * rs * g0[3]);
            w.z = cvtpk(v1[0] * rs * g1[0], v1[1] * rs * g1[1]); w.w = cvtpk(v1[2] * rs * g1[2], v1[3] * rs * g1[3]);
            *(u32x4*)(op + 8 * i) = w; }
    }
    __syncthreads();
}
#undef KSWZ
#undef SBAR
}
namespace dn {
#define DLAS __attribute__((address_space(3)))
typedef short bf16x8 __attribute__((ext_vector_type(8)));
typedef short s16x4 __attribute__((ext_vector_type(4)));
typedef float f32x16 __attribute__((ext_vector_type(16)));
typedef float f32x4 __attribute__((ext_vector_type(4)));
typedef float f32x2_t __attribute__((ext_vector_type(2)));
typedef __bf16 bf16x2_t __attribute__((ext_vector_type(2)));
typedef unsigned u32x4 __attribute__((ext_vector_type(4)));
typedef unsigned u32x2 __attribute__((ext_vector_type(2)));
typedef unsigned short bf16_t;
constexpr int SEQ = 4096, NPC = 7168, NCH = SEQ / 64;
constexpr int IMG_NEGW = 0, IMG_QG = 16384, IMG_KDEC = 32768, IMG_QK = 49152, IMG_BYTES = 55296, IMG_PIECES = 54;
constexpr int U_BYTES = 16384;
constexpr int P_Q = 0, P_K = 16384, P_KT0 = 32768, P_VT0 = 65536, P_T0 = 98304, TP = 68, T_BYTES = 64 * TP * 4, P_ARR0 = P_T0 + 2 * T_BYTES, ARR_BYTES = 1280, P_CW = P_ARR0 + 2 * ARR_BYTES, P_END = P_CW + 3 * 4 * 128 * 4;
constexpr int A_GC = 0, A_BETA = 256, A_BEG = 512, A_DL = 768, A_EGQ = 1024;
constexpr float SCALE = 0.08838834764831845f;

#define KSWZ(row, colB) ((row) * 256 + ((colB) ^ (((row) & 15) << 4)))
__device__ __forceinline__ int v_st(int k, int c) { const int kk = (k & ~0xC) | ((k & 4) << 1) | ((k & 8) >> 1); return ((kk >> 3) * 4 + (c >> 5)) * 512 + ((kk & 7) * 32 + (c & 31)) * 2; }
__device__ __forceinline__ int v_rd_base(int lane) { return ((lane & 3) << 3) | (((lane >> 2) & 3) << 6) | (((lane >> 4) & 1) << 5) | (((lane >> 5) & 1) << 8); }
__device__ __forceinline__ int crow(int r, int hi) { return (r & 3) + 8 * (r >> 2) + 4 * hi; }
__device__ __forceinline__ unsigned cvtpk(float lo, float hi) { f32x2_t v = {lo, hi}; bf16x2_t b = __builtin_convertvector(v, bf16x2_t); return __builtin_bit_cast(unsigned, b); }
__device__ __forceinline__ float bf2f(unsigned short v) { return __uint_as_float((unsigned)v << 16); }
__device__ __forceinline__ bf16x8 pack_regs(const f32x16& x, int s) {
    u32x4 w = {cvtpk(x[8 * s], x[8 * s + 1]), cvtpk(x[8 * s + 2], x[8 * s + 3]), cvtpk(x[8 * s + 4], x[8 * s + 5]), cvtpk(x[8 * s + 6], x[8 * s + 7])};
    return __builtin_bit_cast(bf16x8, w);
}
template <int OFF> __device__ __forceinline__ bf16x8 tr_frag(unsigned vb) {
    s16x4 l, h;
    asm volatile("ds_read_b64_tr_b16 %0, %2 offset:%3\n\tds_read_b64_tr_b16 %1, %2 offset:%4\n\ts_waitcnt lgkmcnt(0)" : "=&v"(l), "=&v"(h) : "v"(vb), "i"(OFF), "i"(OFF + 2048) : "memory");
    return (bf16x8){l[0], l[1], l[2], l[3], h[0], h[1], h[2], h[3]};
}
__device__ __forceinline__ float dpp16_sum(float x) {
    x += __builtin_bit_cast(float, __builtin_amdgcn_update_dpp(0, __builtin_bit_cast(int, x), 0xB1, 0xF, 0xF, true));
    x += __builtin_bit_cast(float, __builtin_amdgcn_update_dpp(0, __builtin_bit_cast(int, x), 0x4E, 0xF, 0xF, true));
    x += __builtin_bit_cast(float, __builtin_amdgcn_update_dpp(0, __builtin_bit_cast(int, x), 0x141, 0xF, 0xF, true));
    x += __builtin_bit_cast(float, __builtin_amdgcn_update_dpp(0, __builtin_bit_cast(int, x), 0x140, 0xF, 0xF, true));
    return x;
}

struct PreArgs { const bf16_t* PROJ; const float* AB; const float* conv_w; const float* a_log; const float* dt_bias; unsigned char* IMG; unsigned char* U; float* EG; };

struct S1Regs { bf16x8 x[11]; float ab0, ab1; };
__device__ __forceinline__ void s1_load(S1Regs& R, const PreArgs& A, int item) {
    const int tid = threadIdx.x, wid = __builtin_amdgcn_readfirstlane(tid >> 6), lane = tid & 63;
    const int bh = item >> 6, n = item & 63, b = bh >> 3, h = bh & 7;
    const size_t m0 = (size_t)b * SEQ + (size_t)n * 64;
    if (wid >= 1 && wid <= 6) {
        const int u = tid - 64, which = u >> 7, run = (u >> 4) & 7, grp = u & 15;
        const bf16_t* src = A.PROJ + (m0 + run * 8 - 3) * NPC + which * 1024 + h * 128 + grp * 8;
        const bool first = (n == 0) && (run == 0);
#pragma unroll
        for (int r = 0; r < 11; ++r) { if (first && r < 3) R.x[r] = bf16x8{}; else R.x[r] = *(const bf16x8*)(src + (size_t)r * NPC); }
    } else if (wid == 7) { R.ab0 = A.AB[(m0 + lane) * 16 + h]; R.ab1 = A.AB[(m0 + lane) * 16 + 8 + h]; }
}
__device__ __forceinline__ void pre_s1(DLAS char* lds, const PreArgs& A, const S1Regs& R, int item, int par) {
    const int tid = threadIdx.x, wid = __builtin_amdgcn_readfirstlane(tid >> 6), lane = tid & 63;
    const int bh = item >> 6, h = bh & 7;
    DLAS char* kt = lds + P_KT0 + par * 16384; DLAS char* vt = lds + P_VT0 + par * 16384; DLAS char* arr = lds + P_ARR0 + par * ARR_BYTES;
    if (wid <= 6) {
        const int u = tid - 64, which = u >> 7, run = (u >> 4) & 7, grp = u & 15, c8 = grp * 8, tok0 = run * 8;
        f32x4 w[4][2];
#pragma unroll
        for (int j = 0; j < 4; ++j) { const DLAS float* wp = (const DLAS float*)(lds + P_CW) + (which * 4 + j) * 128 + c8; w[j][0] = *(const DLAS f32x4*)wp; w[j][1] = *(const DLAS f32x4*)(wp + 4); }
#pragma unroll
        for (int t8 = 0; t8 < 8; ++t8) {
            const int tok = tok0 + t8;
            f32x4 y0 = {0.f, 0.f, 0.f, 0.f}, y1 = {0.f, 0.f, 0.f, 0.f};
#pragma unroll
            for (int j = 0; j < 4; ++j)
#pragma unroll
                for (int e = 0; e < 4; ++e) { y0[e] += w[j][0][e] * bf2f((unsigned short)R.x[t8 + j][e]); y1[e] += w[j][1][e] * bf2f((unsigned short)R.x[t8 + j][4 + e]); }
            float ss = 0.f;
#pragma unroll
            for (int e = 0; e < 4; ++e) { y0[e] = y0[e] * __builtin_amdgcn_rcpf(1.0f + __expf(-y0[e])); y1[e] = y1[e] * __builtin_amdgcn_rcpf(1.0f + __expf(-y1[e])); ss += y0[e] * y0[e] + y1[e] * y1[e]; }
            if (which < 2) { const float rn = __builtin_amdgcn_rsqf(dpp16_sum(ss) + 1e-6f); y0 = y0 * rn; y1 = y1 * rn; }
            const u32x4 pk = {cvtpk(y0[0], y0[1]), cvtpk(y0[2], y0[3]), cvtpk(y1[0], y1[1]), cvtpk(y1[2], y1[3])};
            if (which == 0) *(DLAS u32x4*)(lds + P_Q + KSWZ(tok, c8 * 2)) = pk;
            else if (which == 1) { *(DLAS u32x4*)(lds + P_K + KSWZ(tok, c8 * 2)) = pk; *(DLAS u32x4*)(kt + v_st(tok, c8)) = pk; }
            else *(DLAS u32x4*)(vt + v_st(tok, c8)) = pk;
        }
    } else {
        const float bb = R.ab0, aa = R.ab1;
        const float xx = aa + A.dt_bias[h]; const float sp = xx > 20.f ? xx : log1pf(expf(xx));
        float gc = -expf(A.a_log[h]) * sp;
#pragma unroll
        for (int o = 1; o < 64; o <<= 1) { const float v = __shfl_up(gc, o); if (lane >= o) gc += v; }
        const float glast = __shfl(gc, 63), beta = 1.0f / (1.0f + expf(-bb)), egc = expf(gc);
        ((DLAS float*)(arr + A_GC))[lane] = gc; ((DLAS float*)(arr + A_BETA))[lane] = beta; ((DLAS float*)(arr + A_BEG))[lane] = beta * egc;
        ((DLAS float*)(arr + A_DL))[lane] = expf(glast - gc); ((DLAS float*)(arr + A_EGQ))[lane] = egc * SCALE;
        if (lane == 0) A.EG[item] = expf(glast);
    }
}
__device__ __forceinline__ void pre_s2_job(DLAS char* lds, unsigned char* img, int par, int job, int lane) {
    const int r32 = lane & 31, hi = lane >> 5;
    DLAS char* arr = lds + P_ARR0 + par * ARR_BYTES; const DLAS float* GC = (const DLAS float*)(arr + A_GC);
    DLAS float* T = (DLAS float*)(lds + P_T0 + par * T_BYTES);
    if (job < 6) {
        const bool isL = job < 3; const int tsel = isL ? job : job - 3;
        const int ta = isL ? (tsel >= 1 ? 1 : 0) : (tsel == 2 ? 1 : 0);
        const int tb = isL ? (tsel == 2 ? 1 : 0) : (tsel >= 1 ? 1 : 0);
        f32x16 acc = f32x16{};
        bf16x8 af[8], bfr[8];
#pragma unroll
        for (int d0 = 0; d0 < 8; ++d0) { af[d0] = *(const DLAS bf16x8*)(lds + P_K + KSWZ(32 * ta + r32, (d0 * 16 + hi * 8) * 2)); bfr[d0] = *(const DLAS bf16x8*)(lds + (isL ? P_K : P_Q) + KSWZ(32 * tb + r32, (d0 * 16 + hi * 8) * 2)); }
#pragma unroll
        for (int d0 = 0; d0 < 8; ++d0) acc = __builtin_amdgcn_mfma_f32_32x32x16_bf16(af[d0], bfr[d0], acc, 0, 0, 0);
        const int colx = 32 * tb + r32;
        const float gcol = GC[colx];
        if (isL) {
            const DLAS float* BETA = (const DLAS float*)(arr + A_BETA);
#pragma unroll
            for (int r = 0; r < 16; ++r) { const int i = 32 * ta + crow(r, hi);
                const float v = (colx < i) ? acc[r] * BETA[i] * __expf(GC[i] - gcol) : 0.f;
                T[i * TP + colx] = v; }
        } else {
            f32x16 q;
#pragma unroll
            for (int r = 0; r < 16; ++r) { const int j = 32 * ta + crow(r, hi); q[r] = (j <= colx) ? acc[r] * SCALE * __expf(gcol - GC[j]) : 0.f; }
#pragma unroll
            for (int s = 0; s < 2; ++s) *(bf16x8*)(img + IMG_QK + (tsel * 2 + s) * 1024 + lane * 16) = pack_regs(q, s);
        }
    } else if (job < 8) {
        const DLAS float* EGQ = (const DLAS float*)(arr + A_EGQ);
#pragma unroll
        for (int f = 0; f < 8; ++f) { const int fi = (job - 6) * 8 + f, it = fi >> 3, dkt = (fi >> 1) & 3, s = fi & 1;
            const int i = 32 * it + r32; const float sc = EGQ[i];
            const u32x2 a = *(const DLAS u32x2*)(lds + P_Q + KSWZ(i, (4 * dkt + 2 * s) * 16) + 8 * hi), c = *(const DLAS u32x2*)(lds + P_Q + KSWZ(i, (4 * dkt + 2 * s + 1) * 16) + 8 * hi);
            u32x4 w;
            w.x = cvtpk(__uint_as_float(a.x << 16) * sc, __uint_as_float(a.x & 0xffff0000u) * sc); w.y = cvtpk(__uint_as_float(a.y << 16) * sc, __uint_as_float(a.y & 0xffff0000u) * sc);
            w.z = cvtpk(__uint_as_float(c.x << 16) * sc, __uint_as_float(c.x & 0xffff0000u) * sc); w.w = cvtpk(__uint_as_float(c.y << 16) * sc, __uint_as_float(c.y & 0xffff0000u) * sc);
            *(u32x4*)(img + IMG_QG + ((it * 4 + dkt) * 2 + s) * 1024 + lane * 16) = w; }
    } else {
        const DLAS float* DL = (const DLAS float*)(arr + A_DL);
        const unsigned vb = (unsigned)(uintptr_t)(lds + P_KT0 + par * 16384) + (unsigned)v_rd_base(lane);
#pragma unroll
        for (int q2 = 0; q2 < 2; ++q2) { const int tl = (job - 8) * 2 + q2, dkt = tl >> 1, jt = tl & 1;
            f32x16 acc = f32x16{};
#pragma unroll
            for (int kl = 0; kl < 2; ++kl) {
                const bool on = (kl == (r32 >> 4)) && (hi == ((r32 >> 3) & 1)); const int jj = r32 & 7;
                u32x4 idw = {0u, 0u, 0u, 0u}; const unsigned one = (jj & 1) ? 0x3F800000u : 0x00003F80u;
                if (on) { if ((jj >> 1) == 0) idw.x = one; else if ((jj >> 1) == 1) idw.y = one; else if ((jj >> 1) == 2) idw.z = one; else idw.w = one; }
                const bf16x8 kf = tr_frag<0>(vb + (unsigned)(dkt * 512 + (2 * jt + kl) * 4096));
                __builtin_amdgcn_sched_barrier(0);
                acc = __builtin_amdgcn_mfma_f32_32x32x16_bf16(__builtin_bit_cast(bf16x8, idw), kf, acc, 0, 0, 0);
            }
#pragma unroll
            for (int r = 0; r < 16; ++r) acc[r] *= DL[32 * jt + crow(r, hi)];
#pragma unroll
            for (int s = 0; s < 2; ++s) *(bf16x8*)(img + IMG_KDEC + ((dkt * 2 + jt) * 2 + s) * 1024 + lane * 16) = pack_regs(acc, s);
        }
    }
}
__device__ __forceinline__ void pre_s4(DLAS char* lds, const PreArgs& A, int item, int par) {
    const int tid = threadIdx.x, wid = __builtin_amdgcn_readfirstlane(tid >> 6), lane = tid & 63, r32 = lane & 31, hi = lane >> 5;
    unsigned char* img = A.IMG + (size_t)item * IMG_BYTES;
    DLAS char* arr = lds + P_ARR0 + par * ARR_BYTES; const DLAS float* T = (const DLAS float*)(lds + P_T0 + par * T_BYTES);
    const int it = wid >> 2, d0 = wid & 3;
    const DLAS float* BETA = (const DLAS float*)(arr + A_BETA); const DLAS float* BEG = (const DLAS float*)(arr + A_BEG);
    const unsigned vbV = (unsigned)(uintptr_t)(lds + P_VT0 + par * 16384) + (unsigned)v_rd_base(lane) + (unsigned)(d0 * 512), vbK = (unsigned)(uintptr_t)(lds + P_KT0 + par * 16384) + (unsigned)v_rd_base(lane) + (unsigned)(d0 * 512);
    f32x16 au = f32x16{}, aw = f32x16{};
    const DLAS float* trow = T + (32 * it + r32) * TP + 8 * hi;
#define DN_S4_STEP(ks) do { const f32x4 t0 = *(const DLAS f32x4*)(trow + 16 * (ks)), t1 = *(const DLAS f32x4*)(trow + 16 * (ks) + 4); \
        const f32x4 b0 = *(const DLAS f32x4*)(BETA + 16 * (ks) + 8 * hi), b1 = *(const DLAS f32x4*)(BETA + 16 * (ks) + 8 * hi + 4), g0 = *(const DLAS f32x4*)(BEG + 16 * (ks) + 8 * hi), g1 = *(const DLAS f32x4*)(BEG + 16 * (ks) + 8 * hi + 4); \
        const f32x4 u0 = t0 * b0, u1 = t1 * b1, w0 = t0 * g0, w1 = t1 * g1; \
        const u32x4 tu = {cvtpk(u0[0], u0[1]), cvtpk(u0[2], u0[3]), cvtpk(u1[0], u1[1]), cvtpk(u1[2], u1[3])}, tw = {cvtpk(w0[0], w0[1]), cvtpk(w0[2], w0[3]), cvtpk(w1[0], w1[1]), cvtpk(w1[2], w1[3])}; \
        const bf16x8 vf = tr_frag<(ks) * 4096>(vbV), kf = tr_frag<(ks) * 4096>(vbK); __builtin_amdgcn_sched_barrier(0); \
        au = __builtin_amdgcn_mfma_f32_32x32x16_bf16(__builtin_bit_cast(bf16x8, tu), vf, au, 0, 0, 0); \
        aw = __builtin_amdgcn_mfma_f32_32x32x16_bf16(kf, __builtin_bit_cast(bf16x8, tw), aw, 0, 0, 0); } while (0)
    DN_S4_STEP(0); DN_S4_STEP(1);
    if (it == 1) { DN_S4_STEP(2); DN_S4_STEP(3); }
#undef DN_S4_STEP
    unsigned char* up = A.U + (size_t)item * U_BYTES + (d0 * 2 + it) * 2048 + lane * 32;
    *(bf16x8*)up = pack_regs(au, 0); *(bf16x8*)(up + 16) = pack_regs(au, 1);
#pragma unroll
    for (int r = 0; r < 16; ++r) aw[r] = -aw[r];
#pragma unroll
    for (int s = 0; s < 2; ++s) *(bf16x8*)(img + IMG_NEGW + ((it * 4 + d0) * 2 + s) * 1024 + lane * 16) = pack_regs(aw, s);
}
__device__ __forceinline__ void dn_pre_block(DLAS char* lds, const PreArgs& A, int item0) {
    const int tid = threadIdx.x, wid = __builtin_amdgcn_readfirstlane(tid >> 6), lane = tid & 63;
    { const int h = (item0 >> 6) & 7;
      for (int i = tid; i < 3 * 4 * 128; i += 512) { const int ch = i & 127, j = (i >> 7) & 3, which = i >> 9; ((DLAS float*)(lds + P_CW))[i] = A.conv_w[(size_t)j * 3072 + which * 1024 + h * 128 + ch]; } }
    S1Regs R; R.ab0 = 0.f; R.ab1 = 0.f;
#pragma unroll
    for (int r = 0; r < 11; ++r) R.x[r] = bf16x8{};
    s1_load(R, A, item0);
    __syncthreads();
    for (int k = -1; k < 8; ++k) {
        const int par = k & 1; const bool more = k + 1 < 8, have = k >= 0;
        int zofs; asm volatile("v_mov_b32 %0, 0" : "=v"(zofs));
        DLAS float* T = (DLAS float*)(lds + P_T0 + par * T_BYTES); const DLAS float* Tz = T + zofs;
        if (wid == 0) { if (have) {
                const int half = lane >> 5, c32 = lane & 31;
                const DLAS float* Th = Tz + half * (32 * TP + 32);
                float t[32]; DLAS float* Tw = T + zofs + lane;
#define INVB_LD(buf, i) do { _Pragma("unroll") for (int j4 = 0; j4 < ((i) + 3) / 4; ++j4) buf[j4] = *(const DLAS f32x4*)(Th + (i) * TP + 4 * j4); } while (0)
#define INVB_CP(buf, i) do { float a4[4] = {((i) == c32 + zofs) ? 1.f : 0.f, 0.f, 0.f, 0.f}; \
            _Pragma("unroll") for (int j4 = 0; j4 < ((i) + 3) / 4; ++j4) { _Pragma("unroll") for (int e = 0; e < 4; ++e) if (4 * j4 + e < (i)) a4[e] -= buf[j4][e] * t[4 * j4 + e]; } \
            t[i] = (a4[0] + a4[1]) + (a4[2] + a4[3]); } while (0)
                { f32x4 la[8], lb[8]; INVB_LD(la, 0);
#pragma unroll
                  for (int i = 0; i < 32; i += 2) {
                      INVB_LD(lb, i + 1); __builtin_amdgcn_sched_barrier(0); INVB_CP(la, i); __builtin_amdgcn_sched_barrier(0);
                      if (i + 2 < 32) INVB_LD(la, i + 2); __builtin_amdgcn_sched_barrier(0); INVB_CP(lb, i + 1); __builtin_amdgcn_sched_barrier(0); } }
#undef INVB_LD
#undef INVB_CP
#pragma unroll
                for (int i = 0; i < 32; ++i) Tw[i * TP] = half ? 0.f : t[i];
                if (half) {
#pragma unroll
                    for (int i = 0; i < 32; ++i) Tw[(32 + i) * TP] = t[i]; }
                __builtin_amdgcn_sched_barrier(0);
                f32x16 X = f32x16{}, Dm = f32x16{}; DLAS float* Td = T + zofs + (32 + 4 * half) * TP + c32;
                { const DLAS float* Ab = Tz + (32 + c32) * TP + half;
                  const DLAS float* Bb = Tz + half * TP + c32;
                  float av[16], bv[16];
#pragma unroll
                  for (int s = 0; s < 16; ++s) { av[s] = Ab[2 * s]; bv[s] = Bb[2 * s * TP]; }
                  __builtin_amdgcn_sched_barrier(0);
#pragma unroll
                  for (int s = 0; s < 16; ++s) X = __builtin_amdgcn_mfma_f32_32x32x2f32(av[s], bv[s], X, 0, 0, 0); }
                { const DLAS float* A2 = Tz + (32 + c32) * TP + 32 + 4 * half;
                  float av[16];
#pragma unroll
                  for (int r = 0; r < 16; ++r) av[r] = A2[crow(r, 0)];
                  __builtin_amdgcn_sched_barrier(0);
#pragma unroll
                  for (int r = 0; r < 16; ++r) Dm = __builtin_amdgcn_mfma_f32_32x32x2f32(av[r], X[r], Dm, 0, 0, 0); }
#pragma unroll
                for (int r = 0; r < 16; ++r) Td[crow(r, 0) * TP] = -Dm[r]; } }
        else if (more) { pre_s1(lds, A, R, item0 + k + 1, par ^ 1); if (k + 2 < 8) s1_load(R, A, item0 + k + 2); }
        __syncthreads();
        if (wid == 0) { }
        else if (more) { unsigned char* img1 = A.IMG + (size_t)(item0 + k + 1) * IMG_BYTES;
            for (int jj = 0; jj < 2; ++jj) { if (jj == 1 && wid > 5) break; pre_s2_job(lds, img1, par ^ 1, jj == 0 ? wid - 1 : 6 + wid, lane); } }
        if (have) pre_s4(lds, A, item0 + k, par);
        __syncthreads();
    }
}

constexpr int S_IMG = 0, S_OS = 2 * IMG_BYTES, OSP = 136, S_GN = S_OS + 2 * 64 * OSP * 2, S_END = S_GN + 512;
struct ScanArgs { const unsigned char* IMG; const unsigned char* U; const float* EG; const bf16_t* PROJ; bf16_t* MIX; const float* dn_norm; };
__device__ __forceinline__ void dn_scan(DLAS char* lds, const ScanArgs& A, int bh) {
    const int tid = threadIdx.x, wid = __builtin_amdgcn_readfirstlane(tid >> 6), lane = tid & 63, r32 = lane & 31, hi = lane >> 5;
    const int b = bh >> 3, h = bh & 7;
    const size_t item0 = (size_t)bh * NCH;
    const __amdgpu_buffer_rsrc_t rs = __builtin_amdgcn_make_buffer_rsrc((void*)A.IMG, 0, 0x7fffffff, 0x00020000);
#define SC_DMA(n, bf) do { const unsigned so_ = (unsigned)((item0 + (n)) * IMG_BYTES); \
        _Pragma("unroll") for (int q_ = 0; q_ < 7; ++q_) { const int pc_ = wid + 8 * q_; if (pc_ < IMG_PIECES) \
            __builtin_amdgcn_raw_ptr_buffer_load_lds(rs, (DLAS void*)(lds + S_IMG + (bf) * IMG_BYTES + pc_ * 1024), 16, (unsigned)(lane * 16), so_ + (unsigned)(pc_ * 1024), 0, 0); } } while (0)
    const bool comp = wid < 4;
    const int d0 = wid & 3;
    f32x16 S[4]; bf16x8 Sb[4][2];
#pragma unroll
    for (int i = 0; i < 4; ++i) { S[i] = f32x16{}; Sb[i][0] = bf16x8{}; Sb[i][1] = bf16x8{}; }
    unsigned pf[16]; float egn = 0.f;
#pragma unroll
    for (int i = 0; i < 16; ++i) pf[i] = 0u;
    if (tid < 128) ((DLAS float*)(lds + S_GN))[tid] = A.dn_norm[tid];
#define SC_PREF(n) do { if (comp) { const unsigned char* up_ = A.U + (item0 + (n)) * U_BYTES + (d0 * 2) * 2048 + lane * 32; \
            const u32x4 a_ = *(const u32x4*)up_, b_ = *(const u32x4*)(up_ + 16), c_ = *(const u32x4*)(up_ + 2048), d_ = *(const u32x4*)(up_ + 2048 + 16); egn = A.EG[item0 + (n)]; \
            pf[0] = a_.x; pf[1] = a_.y; pf[2] = a_.z; pf[3] = a_.w; pf[4] = b_.x; pf[5] = b_.y; pf[6] = b_.z; pf[7] = b_.w; pf[8] = c_.x; pf[9] = c_.y; pf[10] = c_.z; pf[11] = c_.w; pf[12] = d_.x; pf[13] = d_.y; pf[14] = d_.z; pf[15] = d_.w; } } while (0)
#define SC_PREFZ(n) do { if (!comp) { _Pragma("unroll") for (int i4 = 0; i4 < 4; ++i4) { const size_t m_ = (size_t)b * SEQ + (size_t)(n) * 64 + (wid - 4) * 16 + 4 * i4 + (lane >> 4); \
            const u32x4 z_ = *(const u32x4*)(A.PROJ + m_ * NPC + 3072 + h * 128 + 8 * (lane & 15)); pf[4 * i4] = z_.x; pf[4 * i4 + 1] = z_.y; pf[4 * i4 + 2] = z_.z; pf[4 * i4 + 3] = z_.w; } } } while (0)
#define SC_NORM(OSB, ZA, cn) do { _Pragma("unroll") for (int i4 = 0; i4 < 4; ++i4) { const int t_ = (wid - 4) * 16 + 4 * i4 + (lane >> 4); \
            const u32x4 ov_ = *(const DLAS u32x4*)((OSB) + t_ * OSP + 8 * (lane & 15)); float of_[8], zf_[8]; \
            of_[0] = __uint_as_float(ov_.x << 16); of_[1] = __uint_as_float(ov_.x & 0xffff0000u); of_[2] = __uint_as_float(ov_.y << 16); of_[3] = __uint_as_float(ov_.y & 0xffff0000u); \
            of_[4] = __uint_as_float(ov_.z << 16); of_[5] = __uint_as_float(ov_.z & 0xffff0000u); of_[6] = __uint_as_float(ov_.w << 16); of_[7] = __uint_as_float(ov_.w & 0xffff0000u); \
            _Pragma("unroll") for (int e_ = 0; e_ < 4; ++e_) { zf_[2 * e_] = __uint_as_float(ZA[4 * i4 + e_] << 16); zf_[2 * e_ + 1] = __uint_as_float(ZA[4 * i4 + e_] & 0xffff0000u); } \
            float ss_ = 0.f; _Pragma("unroll") for (int e_ = 0; e_ < 8; ++e_) ss_ += of_[e_] * of_[e_]; \
            const float rstd_ = __builtin_amdgcn_rsqf(dpp16_sum(ss_) * (1.0f / 128.0f) + 1e-6f); float y_[8]; \
            const f32x4 g0_ = *(const DLAS f32x4*)(lds + S_GN + 32 * (lane & 15)), g1_ = *(const DLAS f32x4*)(lds + S_GN + 32 * (lane & 15) + 16); \
            _Pragma("unroll") for (int e_ = 0; e_ < 8; ++e_) y_[e_] = of_[e_] * rstd_ * (e_ < 4 ? g0_[e_ & 3] : g1_[e_ & 3]) * (zf_[e_] * __builtin_amdgcn_rcpf(1.0f + __expf(-zf_[e_]))); \
            const u32x4 w_ = {cvtpk(y_[0], y_[1]), cvtpk(y_[2], y_[3]), cvtpk(y_[4], y_[5]), cvtpk(y_[6], y_[7])}; \
            *(u32x4*)(A.MIX + ((size_t)b * SEQ + (size_t)(cn) * 64 + t_) * 2048 + h * 128 + 8 * (lane & 15)) = w_; } } while (0)
    SC_PREF(0); SC_DMA(0, 0);
    __syncthreads();
    for (int n = 0; n < NCH; ++n) {
        const int cur = n & 1;
        unsigned pc[16]; const float eg = egn;
#pragma unroll
        for (int i = 0; i < 16; ++i) pc[i] = pf[i];
        if (n + 1 < NCH) SC_PREF(n + 1);
        SC_PREFZ(n);
        if (n + 1 < NCH) SC_DMA(n + 1, cur ^ 1);
        if (comp) {
            const DLAS char* im = lds + S_IMG + cur * IMG_BYTES + lane * 16;
#define FR(off, pc) (*(const DLAS bf16x8*)(im + (off) + (pc) * 1024))
            f32x16 vn[2], o[2];
#pragma unroll
            for (int it = 0; it < 2; ++it) {
#pragma unroll
                for (int e = 0; e < 8; ++e) { const unsigned w = pc[it * 8 + e]; vn[it][2 * e] = __uint_as_float(w << 16); vn[it][2 * e + 1] = __uint_as_float(w & 0xffff0000u); }
            }
            bf16x8 fa[4], fb[4];
#define LD4(dst, off, pc0, cnt) do { _Pragma("unroll") for (int q_ = 0; q_ < (cnt); ++q_) dst[q_] = FR(off, (pc0) + q_); } while (0)
#define SB0() __builtin_amdgcn_sched_barrier(0)
#define MM4(acc, fr, b0, b1, b2, b3) do { acc = __builtin_amdgcn_mfma_f32_32x32x16_bf16(fr[0], b0, acc, 0, 0, 0); acc = __builtin_amdgcn_mfma_f32_32x32x16_bf16(fr[1], b1, acc, 0, 0, 0); \
                acc = __builtin_amdgcn_mfma_f32_32x32x16_bf16(fr[2], b2, acc, 0, 0, 0); acc = __builtin_amdgcn_mfma_f32_32x32x16_bf16(fr[3], b3, acc, 0, 0, 0); } while (0)
            LD4(fa, IMG_NEGW, 0, 4); LD4(fb, IMG_NEGW, 4, 4); SB0();
            MM4(vn[0], fa, Sb[0][0], Sb[0][1], Sb[1][0], Sb[1][1]); SB0(); LD4(fa, IMG_NEGW, 8, 4); SB0();
            MM4(vn[0], fb, Sb[2][0], Sb[2][1], Sb[3][0], Sb[3][1]); SB0(); LD4(fb, IMG_NEGW, 12, 4); SB0();
            MM4(vn[1], fa, Sb[0][0], Sb[0][1], Sb[1][0], Sb[1][1]); SB0(); LD4(fa, IMG_QG, 0, 4); SB0();
            MM4(vn[1], fb, Sb[2][0], Sb[2][1], Sb[3][0], Sb[3][1]); SB0(); LD4(fb, IMG_QG, 4, 4); SB0();
            o[0] = f32x16{}; o[1] = f32x16{};
            MM4(o[0], fa, Sb[0][0], Sb[0][1], Sb[1][0], Sb[1][1]); SB0(); LD4(fa, IMG_QG, 8, 4); SB0();
            MM4(o[0], fb, Sb[2][0], Sb[2][1], Sb[3][0], Sb[3][1]); SB0(); LD4(fb, IMG_QG, 12, 4); SB0();
            bf16x8 vb[2][2];
#pragma unroll
            for (int jt = 0; jt < 2; ++jt) { vb[jt][0] = pack_regs(vn[jt], 0); vb[jt][1] = pack_regs(vn[jt], 1); }
            MM4(o[1], fa, Sb[0][0], Sb[0][1], Sb[1][0], Sb[1][1]); SB0(); LD4(fa, IMG_QK, 0, 4); SB0();
            MM4(o[1], fb, Sb[2][0], Sb[2][1], Sb[3][0], Sb[3][1]); SB0(); LD4(fb, IMG_QK, 4, 2); SB0();
            o[0] = __builtin_amdgcn_mfma_f32_32x32x16_bf16(fa[0], vb[0][0], o[0], 0, 0, 0); o[0] = __builtin_amdgcn_mfma_f32_32x32x16_bf16(fa[1], vb[0][1], o[0], 0, 0, 0);
            o[1] = __builtin_amdgcn_mfma_f32_32x32x16_bf16(fa[2], vb[0][0], o[1], 0, 0, 0); o[1] = __builtin_amdgcn_mfma_f32_32x32x16_bf16(fa[3], vb[0][1], o[1], 0, 0, 0);
            SB0(); LD4(fa, IMG_KDEC, 0, 4); SB0();
            o[1] = __builtin_amdgcn_mfma_f32_32x32x16_bf16(fb[0], vb[1][0], o[1], 0, 0, 0); o[1] = __builtin_amdgcn_mfma_f32_32x32x16_bf16(fb[1], vb[1][1], o[1], 0, 0, 0);
            SB0(); LD4(fb, IMG_KDEC, 4, 4); SB0();
#pragma unroll
            for (int dkt = 0; dkt < 4; ++dkt)
#pragma unroll
                for (int r = 0; r < 16; ++r) S[dkt][r] *= eg;
            MM4(S[0], fa, vb[0][0], vb[0][1], vb[1][0], vb[1][1]); SB0(); LD4(fa, IMG_KDEC, 8, 4); SB0();
            MM4(S[1], fb, vb[0][0], vb[0][1], vb[1][0], vb[1][1]); SB0(); LD4(fb, IMG_KDEC, 12, 4); SB0();
            MM4(S[2], fa, vb[0][0], vb[0][1], vb[1][0], vb[1][1]); SB0();
            MM4(S[3], fb, vb[0][0], vb[0][1], vb[1][0], vb[1][1]);
#pragma unroll
            for (int dkt = 0; dkt < 4; ++dkt) { Sb[dkt][0] = pack_regs(S[dkt], 0); Sb[dkt][1] = pack_regs(S[dkt], 1); }
#undef LD4
#undef SB0
#undef MM4
#undef FR
            DLAS bf16_t* os = (DLAS bf16_t*)(lds + S_OS + cur * (64 * OSP * 2)) + 32 * d0 + r32;
#pragma unroll
            for (int it = 0; it < 2; ++it)
#pragma unroll
                for (int r = 0; r < 16; r += 2) { const unsigned pk = cvtpk(o[it][r], o[it][r + 1]); os[(32 * it + crow(r, hi)) * OSP] = (bf16_t)(pk & 0xffffu); os[(32 * it + crow(r + 1, hi)) * OSP] = (bf16_t)(pk >> 16); }
        } else if (n > 0) {
            const DLAS bf16_t* os = (const DLAS bf16_t*)(lds + S_OS + (cur ^ 1) * (64 * OSP * 2));
            SC_NORM(os, pc, n - 1);
        }
        __syncthreads();
    }
    if (!comp) { const DLAS bf16_t* os = (const DLAS bf16_t*)(lds + S_OS + ((NCH - 1) & 1) * (64 * OSP * 2)); SC_NORM(os, pf, NCH - 1); }
    __syncthreads();
#undef SC_DMA
#undef SC_PREF
#undef SC_PREFZ
#undef SC_NORM
}
#undef KSWZ
}
#define GAS __attribute__((address_space(1)))
#define LAS __attribute__((address_space(3)))
typedef unsigned short bf16;
typedef unsigned v4u __attribute__((ext_vector_type(4)));
typedef float f32x4 __attribute__((ext_vector_type(4)));
typedef short bf16x8 __attribute__((ext_vector_type(8)));
#define LDS_WAIT() asm volatile("s_waitcnt lgkmcnt(0)" ::: "memory")

constexpr int BATCH = 4, SEQ = 4096, DM = 2048, M = BATCH * SEQ, NP = 7168, IN_COLS = 7184, FF = 8192;
constexpr int DNH = 8, DFH = 4;
constexpr int NWAVES = 8;
constexpr int LDS_BYTES = 147456;
constexpr size_t MiB = 1u << 20;
constexpr size_t WS_CTL = 0;
constexpr size_t WS_WIN = 2 * MiB;
constexpr size_t WS_WO = 30 * MiB;
constexpr size_t WS_WUP = 38 * MiB;
constexpr size_t WS_WDN = 70 * MiB;
constexpr size_t WS_AB = 102 * MiB;
constexpr size_t WS_SS1 = 103 * MiB;
constexpr size_t WS_SS2 = 105 * MiB;
constexpr size_t WS_MIX = 108 * MiB;
constexpr size_t WS_BIG = 172 * MiB;
constexpr size_t WS_PROJ = WS_BIG, WS_U = WS_BIG + 224 * MiB, WS_HID = WS_BIG, WS_H1B = WS_BIG + 256 * MiB;
constexpr size_t WS_IRS = 256 * 1024;
constexpr size_t WS_EG = 512 * 1024;
constexpr size_t WS_END = WS_BIG + 320 * MiB;

__device__ __forceinline__ unsigned f2bf(float f) { unsigned u = __builtin_bit_cast(unsigned, f); return (u + 0x7fffu + ((u >> 16) & 1u)) >> 16; }
__device__ __forceinline__ unsigned pk2(float lo, float hi) { unsigned r; asm("v_cvt_pk_bf16_f32 %0, %1, %2" : "=v"(r) : "v"(lo), "v"(hi)); return r; }
__device__ __forceinline__ float bf2f(unsigned short v) { return __builtin_bit_cast(float, (unsigned)v << 16); }
__device__ __forceinline__ float wave_sum(float v) {
    v += __builtin_bit_cast(float, __builtin_amdgcn_update_dpp(0, __builtin_bit_cast(int, v), 0xB1, 0xF, 0xF, true));
    v += __builtin_bit_cast(float, __builtin_amdgcn_update_dpp(0, __builtin_bit_cast(int, v), 0x4E, 0xF, 0xF, true));
    v += __builtin_bit_cast(float, __builtin_amdgcn_update_dpp(0, __builtin_bit_cast(int, v), 0x141, 0xF, 0xF, true));
    v += __builtin_bit_cast(float, __builtin_amdgcn_update_dpp(0, __builtin_bit_cast(int, v), 0x140, 0xF, 0xF, true));
    { auto r = __builtin_amdgcn_permlane32_swap(__float_as_uint(v), __float_as_uint(v), false, false); v = __uint_as_float(r[0]) + __uint_as_float(r[1]); }
    return v + __shfl_xor(v, 16);
}

typedef GAS unsigned gu32;
#define RLX_AGENT __ATOMIC_RELAXED, __HIP_MEMORY_SCOPE_AGENT
#define XB_TMO      128
#define XB_XCNT(j)  (256  + 64 * (j))
#define XB_XSUB(j)  (1280 + 64 * (j))
#define XB_XGEN(j)  (2304 + 64 * (j))
#define XB_TOP      3328
#define XB_TOPGEN   3392
#define XCD_BAR_WORDS 3456
#define XB_SPIN_CAP (1u << 18)

__device__ __forceinline__ unsigned xb_ld(unsigned* p)              { return __hip_atomic_load(p, __ATOMIC_RELAXED, __HIP_MEMORY_SCOPE_AGENT); }
__device__ __forceinline__ unsigned xb_add(unsigned* p, unsigned v) { return __hip_atomic_fetch_add(p, v, __ATOMIC_RELAXED, __HIP_MEMORY_SCOPE_AGENT); }
__device__ __forceinline__ unsigned xb_xcc_id() { return (unsigned)__builtin_amdgcn_s_getreg((3 << 11) | 20) & 0xFu; }
#define XB_SPIN(cond, bar) do { unsigned _sp = 0; while (cond) { __builtin_amdgcn_s_sleep(1); \
    if ((++_sp & 255u) == 0u) { if (xb_ld(&(bar)[XB_TMO])) break; if (_sp > XB_SPIN_CAP) { atomicAdd(&(bar)[XB_TMO], 1u); break; } } } } while (0)

struct XcdBarrier {
    unsigned* bar; unsigned x;
    volatile LAS unsigned* st;
};

__device__ __forceinline__ XcdBarrier xcd_barrier_post(unsigned* bar, volatile LAS unsigned* st) {
    XcdBarrier b; b.bar = bar; b.x = xb_xcc_id(); b.st = st;
    if (threadIdx.x == 0) st[2] = xb_add(&bar[XB_XCNT(b.x)], 1u);
    return b;
}
__device__ __forceinline__ void xcd_barrier_complete(unsigned* bar, unsigned x, unsigned& nloc, unsigned& nx, unsigned& uni) {
    const unsigned G = gridDim.x * gridDim.y * gridDim.z;
    unsigned sum, cnt, mine, sp = 0u, c32;
    for (;;) {
        sum = 0u; cnt = 0u; mine = 0u; c32 = 0u;
#pragma unroll
        for (unsigned j = 0; j < 16; ++j) { const unsigned c = xb_ld(&bar[XB_XCNT(j)]); sum += c; cnt += (c > 0u) ? 1u : 0u; mine = (j == x) ? c : mine; c32 += (j < 8u && c == 32u) ? 1u : 0u; }
        if (sum == G) break;
        __builtin_amdgcn_s_sleep(1);
        if ((++sp & 255u) == 0u) { if (xb_ld(&bar[XB_TMO])) break; if (sp > XB_SPIN_CAP) { atomicAdd(&bar[XB_TMO], 1u); break; } }
    }
    nloc = mine > 0u ? mine : 1u; nx = cnt > 0u ? cnt : 1u;
    uni = (sum == G && G == 256u && c32 == 8u) ? 1u : 0u;
}

__device__ __forceinline__ void xcd_barrier(const XcdBarrier& b) {
    asm volatile("s_waitcnt vmcnt(0)" ::: "memory");
    __syncthreads();
    if (threadIdx.x == 0) {
        unsigned* bar = b.bar;
        __builtin_amdgcn_s_waitcnt(0);
        unsigned nloc = b.st[0], nx = b.st[1];
        if (nloc == 0u) { unsigned uni; xcd_barrier_complete(bar, b.x, nloc, nx, uni); b.st[0] = nloc; b.st[1] = nx; b.st[3] = uni; }
        const unsigned old = xb_add(&bar[XB_XSUB(b.x)], 1u);
        const unsigned gen = old / nloc;
        if (old + 1u == (gen + 1u) * nloc) {
            __builtin_amdgcn_fence(__ATOMIC_RELEASE, "agent");
            asm volatile("s_waitcnt vmcnt(0)" ::: "memory");
            const unsigned og = xb_add(&bar[XB_TOP], 1u);
            const unsigned tg = og / nx;
            if (og + 1u == (tg + 1u) * nx) xb_add(&bar[XB_TOPGEN], 1u);
            else XB_SPIN(xb_ld(&bar[XB_TOPGEN]) == tg, bar);
            __builtin_amdgcn_fence(__ATOMIC_ACQUIRE, "agent");
            xb_add(&bar[XB_XGEN(b.x)], 1u);
            asm volatile("s_waitcnt vmcnt(0)" ::: "memory");
        } else {
            XB_SPIN(xb_ld(&bar[XB_XGEN(b.x)]) == gen, bar);
            __builtin_amdgcn_fence(__ATOMIC_ACQUIRE, "agent");
            asm volatile("s_waitcnt vmcnt(0)" ::: "memory");
        }
    }
    __syncthreads();
}

__device__ __forceinline__ void xcd_barrier_local(const XcdBarrier& b) {
    asm volatile("s_waitcnt vmcnt(0)" ::: "memory");
    __syncthreads();
    if (threadIdx.x == 0) {
        unsigned* bar = b.bar;
        __builtin_amdgcn_s_waitcnt(0);
        const unsigned nloc = b.st[0];
        const unsigned old = xb_add(&bar[XB_XSUB(b.x)], 1u);
        const unsigned gen = old / nloc;
        if (old + 1u == (gen + 1u) * nloc) xb_add(&bar[XB_XGEN(b.x)], 1u);
        else XB_SPIN(xb_ld(&bar[XB_XGEN(b.x)]) == gen, bar);
        __builtin_amdgcn_fence(__ATOMIC_ACQUIRE, "agent");
        asm volatile("s_waitcnt vmcnt(0)" ::: "memory");
    }
    __syncthreads();
}

constexpr size_t WS_BAR = 64 * 1024;
constexpr int LDS_MISC = LDS_BYTES - 64;
struct Frame {
    LAS unsigned char* lds;
    int tid, lane, wave, G, bid, cv, uni;
    const float* in[18]; float* out; unsigned char* ws;
};

__device__ __forceinline__ void p0_transpose_item(const float* W, int ldw, int K, bf16* WT, int k0, int csrc, int ndst, const float* ksc, LAS float* scr, int lane) {
    float wv[32];
#pragma unroll
    for (int i = 0; i < 32; ++i) wv[i] = W[(size_t)(k0 + 2 * i + (lane >> 5)) * ldw + csrc + (lane & 31)];
    if (ksc) {
#pragma unroll
        for (int i = 0; i < 32; ++i) wv[i] *= ksc[k0 + 2 * i + (lane >> 5)]; }
#pragma unroll
    for (int i = 0; i < 32; ++i) scr[(2 * i + (lane >> 5)) * 33 + (lane & 31)] = wv[i];
    LDS_WAIT(); asm volatile("" ::: "memory");
    const int c = lane & 7;
#pragma unroll
    for (int j = 0; j < 4; ++j) { const int n = (lane >> 3) + 8 * j; const LAS float* s = scr + (8 * c) * 33 + n;
        v4u o; o.x = pk2(s[0 * 33], s[1 * 33]); o.y = pk2(s[2 * 33], s[3 * 33]); o.z = pk2(s[4 * 33], s[5 * 33]); o.w = pk2(s[6 * 33], s[7 * 33]);
        *(GAS v4u*)(WT + (size_t)(ndst + n) * K + k0 + 8 * c) = o; }
    LDS_WAIT(); asm volatile("" ::: "memory");
}
constexpr int I_IN = (DM / 64) * (NP / 32), I_O = (DM / 64) * (DM / 32), I_UP = (DM / 64) * (FF / 32), I_DN = (FF / 64) * (DM / 32), NITEMS = I_IN + I_O + I_UP + I_DN;
__device__ __forceinline__ void p0_convert(Frame& F, int it_lo, int it_hi, int gw, int nw) {
    const float* w_in = F.in[2]; const float* w_o = F.in[13]; const float* mlp_norm = F.in[14]; const float* w_up = F.in[15]; const float* w_down = F.in[16];
    bf16* WIN = (bf16*)(F.ws + WS_WIN); bf16* WO = (bf16*)(F.ws + WS_WO); bf16* WUP = (bf16*)(F.ws + WS_WUP); bf16* WDN = (bf16*)(F.ws + WS_WDN);
    LAS float* scr = (LAS float*)(F.lds + F.wave * 16384);
    for (int it = it_lo + gw; it < it_hi; it += nw) {
        int r = it;
        if (r < I_IN) { const int nblk = NP / 32, kb = r / nblk, nb = r % nblk, n0 = 32 * nb; p0_transpose_item(w_in, IN_COLS, DM, WIN, 64 * kb, n0 + (n0 >= 4096 ? 16 : 0), n0, F.in[1], scr, F.lane); continue; } r -= I_IN;
        if (r < I_O) { const int nblk = DM / 32, kb = r / nblk, nb = r % nblk; p0_transpose_item(w_o, DM, DM, WO, 64 * kb, 32 * nb, 32 * nb, nullptr, scr, F.lane); continue; } r -= I_O;
        if (r < I_UP) { const int nblk = FF / 32, kb = r / nblk, nb = r % nblk; p0_transpose_item(w_up, FF, DM, WUP, 64 * kb, 32 * nb, 32 * nb, mlp_norm, scr, F.lane); continue; } r -= I_UP;
        { const int nblk = DM / 32, kb = r / nblk, nb = r % nblk; p0_transpose_item(w_down, DM, FF, WDN, 64 * kb, 32 * nb, 32 * nb, nullptr, scr, F.lane); }
    }
}
struct TItem { const float* W; bf16* WT; const float* ksc; int ldw, K, k0, csrc, ndst; };
__device__ __forceinline__ void p0_item_decode(Frame& F, int it, TItem& t) {
    int r = it;
    if (r < I_IN) { const int nblk = NP / 32, kb = r / nblk, nb = r % nblk, n0 = 32 * nb; t = TItem{F.in[2], (bf16*)(F.ws + WS_WIN), F.in[1], IN_COLS, DM, 64 * kb, n0 + (n0 >= 4096 ? 16 : 0), n0}; return; } r -= I_IN;
    if (r < I_O) { const int nblk = DM / 32, kb = r / nblk, nb = r % nblk; t = TItem{F.in[13], (bf16*)(F.ws + WS_WO), nullptr, DM, DM, 64 * kb, 32 * nb, 32 * nb}; return; } r -= I_O;
    if (r < I_UP) { const int nblk = FF / 32, kb = r / nblk, nb = r % nblk; t = TItem{F.in[15], (bf16*)(F.ws + WS_WUP), F.in[14], FF, DM, 64 * kb, 32 * nb, 32 * nb}; return; } r -= I_UP;
    { const int nblk = DM / 32, kb = r / nblk, nb = r % nblk; t = TItem{F.in[16], (bf16*)(F.ws + WS_WDN), nullptr, DM, FF, 64 * kb, 32 * nb, 32 * nb}; }
}
__device__ __forceinline__ void p0_item_load(const TItem& t, float (&wv)[32], int lane) {
#pragma unroll
    for (int i = 0; i < 32; ++i) wv[i] = t.W[(size_t)(t.k0 + 2 * i + (lane >> 5)) * t.ldw + t.csrc + (lane & 31)];
}
__device__ __forceinline__ void p0_item_store(const TItem& t, float (&wv)[32], LAS float* scr, int lane) {
    if (t.ksc) {
#pragma unroll
        for (int i = 0; i < 32; ++i) wv[i] *= t.ksc[t.k0 + 2 * i + (lane >> 5)]; }
#pragma unroll
    for (int i = 0; i < 32; ++i) scr[(2 * i + (lane >> 5)) * 33 + (lane & 31)] = wv[i];
    LDS_WAIT(); asm volatile("" ::: "memory");
    const int c = lane & 7;
#pragma unroll
    for (int j = 0; j < 4; ++j) { const int n = (lane >> 3) + 8 * j; const LAS float* s = scr + (8 * c) * 33 + n;
        v4u o; o.x = pk2(s[0 * 33], s[1 * 33]); o.y = pk2(s[2 * 33], s[3 * 33]); o.z = pk2(s[4 * 33], s[5 * 33]); o.w = pk2(s[6 * 33], s[7 * 33]);
        *(GAS v4u*)(t.WT + (size_t)(t.ndst + n) * t.K + t.k0 + 8 * c) = o; }
    LDS_WAIT(); asm volatile("" ::: "memory");
}
__device__ __forceinline__ void p0_convert_pipe(Frame& F, int it_lo, int it_hi, int gw, int nw) {
    LAS float* scr = (LAS float*)(F.lds + F.wave * 16384);
    TItem t0{}, t1{}, t2{}, t3{}; float w0[32], w1[32], w2[32], w3[32]; int it = it_lo + gw;
#define CV_LD(t, w, i) do { if ((i) < it_hi) { p0_item_decode(F, (i), t); p0_item_load(t, w, F.lane); } } while (0)
#define CV_ST(t, w, i) do { if ((i) < it_hi) p0_item_store(t, w, scr, F.lane); } while (0)
    CV_LD(t0, w0, it); CV_LD(t1, w1, it + nw); CV_LD(t2, w2, it + 2 * nw);
    while (it < it_hi) {
        CV_LD(t3, w3, it + 3 * nw); CV_ST(t0, w0, it);
        CV_LD(t0, w0, it + 4 * nw); CV_ST(t1, w1, it + nw);
        CV_LD(t1, w1, it + 5 * nw); CV_ST(t2, w2, it + 2 * nw);
        CV_LD(t2, w2, it + 6 * nw); CV_ST(t3, w3, it + 3 * nw);
        it += 4 * nw;
    }
#undef CV_LD
#undef CV_ST
}
constexpr int CONV_B0 = 32, CONV_NB = 64;
__device__ __forceinline__ void p0_prologue(Frame& F) {
    const float* x = F.in[0]; const float* attn_norm = F.in[1]; const float* w_in = F.in[2];
    bf16* XN = (bf16*)(F.ws + WS_H1B); float* AB = (float*)(F.ws + WS_AB); float* IRS = (float*)(F.ws + WS_IRS);
    if (F.bid == 0 && F.tid == 0) *(unsigned*)(F.ws + WS_CTL) = 0u;
    const int gw = F.bid * NWAVES + F.wave, NGW = F.G * NWAVES;
    p0_convert(F, 0, F.G >= CONV_B0 + CONV_NB ? I_IN : NITEMS, gw, NGW);
    __syncthreads();
    LAS float* WAB = (LAS float*)F.lds;
    { f32x4 wv[16];
#pragma unroll
      for (int q = 0; q < 16; ++q) { const int i = F.tid + q * (NWAVES * 64), k = i >> 2, c4 = i & 3; wv[q] = *(const f32x4*)(w_in + (size_t)k * IN_COLS + 4096 + 4 * c4); }
      __builtin_amdgcn_sched_barrier(0);
#pragma unroll
      for (int q = 0; q < 16; ++q) { const int i = F.tid + q * (NWAVES * 64), k = i >> 2, c4 = i & 3;
          WAB[(4 * c4 + 0) * DM + k] = wv[q][0]; WAB[(4 * c4 + 1) * DM + k] = wv[q][1]; WAB[(4 * c4 + 2) * DM + k] = wv[q][2]; WAB[(4 * c4 + 3) * DM + k] = wv[q][3]; } }
    __syncthreads();
    f32x4 g4[8];
#pragma unroll
    for (int j = 0; j < 8; ++j) g4[j] = *(const f32x4*)(attn_norm + 4 * F.lane + 256 * j);
    for (int m = gw; m < M; m += NGW) {
        const f32x4* xr = (const f32x4*)(x + (size_t)m * DM) + F.lane;
        f32x4 v[8]; float s = 0.f;
#pragma unroll
        for (int j = 0; j < 8; ++j) { v[j] = xr[64 * j]; s += (v[j][0] * v[j][0] + v[j][1] * v[j][1]) + (v[j][2] * v[j][2] + v[j][3] * v[j][3]); }
        const float rstd = 1.0f / sqrtf(wave_sum(s) * (1.0f / DM) + 1e-6f);
        unsigned long long* o8 = (unsigned long long*)(XN + (size_t)m * DM) + F.lane;
#pragma unroll
        for (int j = 0; j < 8; ++j) { v[j] = v[j] * rstd; o8[64 * j] = (unsigned long long)pk2(v[j][0], v[j][1]) | ((unsigned long long)pk2(v[j][2], v[j][3]) << 32); v[j] = v[j] * g4[j]; }
        if (F.lane == 0) IRS[m] = 1.0f / rstd;
        float a16[16];
#pragma unroll
        for (int c = 0; c < 16; ++c) { const LAS f32x4* wp = (const LAS f32x4*)(WAB + c * DM) + F.lane; float a = 0.f;
#pragma unroll
            for (int j = 0; j < 8; ++j) { const f32x4 w = wp[64 * j]; a += (v[j][0] * w[0] + v[j][1] * w[1]) + (v[j][2] * w[2] + v[j][3] * w[3]); }
            a16[c] = a; if ((c & 1) == 1) __builtin_amdgcn_sched_barrier(0); }
        float b8[8];
#pragma unroll
        for (int i = 0; i < 8; ++i) { auto r = __builtin_amdgcn_permlane32_swap(__float_as_uint(a16[i]), __float_as_uint(a16[i + 8]), false, false);
            b8[i] = __uint_as_float(r[0]) + __uint_as_float(r[1]); }
#pragma unroll
        for (int i = 0; i < 8; ++i) {
            float x = b8[i];
            x += __builtin_bit_cast(float, __builtin_amdgcn_update_dpp(0, __builtin_bit_cast(int, x), 0xB1, 0xF, 0xF, true));
            x += __builtin_bit_cast(float, __builtin_amdgcn_update_dpp(0, __builtin_bit_cast(int, x), 0x4E, 0xF, 0xF, true));
            x += __builtin_bit_cast(float, __builtin_amdgcn_update_dpp(0, __builtin_bit_cast(int, x), 0x141, 0xF, 0xF, true));
            x += __builtin_bit_cast(float, __builtin_amdgcn_update_dpp(0, __builtin_bit_cast(int, x), 0x140, 0xF, 0xF, true));
            b8[i] = x; }
        float mine = 0.f;
#pragma unroll
        for (int i = 0; i < 8; ++i) { const float t = b8[i] + __shfl_xor(b8[i], 16); if ((F.lane & 7) == i) mine = t; }
        if ((F.lane & 31) < 8) AB[(size_t)m * 16 + (F.lane >> 5) * 8 + (F.lane & 7)] = mine;
    }
}

__device__ __forceinline__ void final_norm_phase(Frame& F) {
    const float* SS2 = (const float*)(F.ws + WS_SS2); const float* fn = F.in[17]; const bf16* HB = (const bf16*)(F.ws + WS_H1B);
    const int gw = F.bid * NWAVES + F.wave, NGW = F.G * NWAVES;
    f32x4 g4[4][2];
#pragma unroll
    for (int j = 0; j < 4; ++j) { g4[j][0] = *(const f32x4*)(fn + 512 * j + 8 * F.lane); g4[j][1] = *(const f32x4*)(fn + 512 * j + 8 * F.lane + 4); }
    const int rowb = F.uni ? 2048 * (F.cv & 7) + (F.cv >> 3) * NWAVES + F.wave : gw, rows = F.uni ? 256 : NGW;
    for (int m0 = rowb; m0 < (F.uni ? rowb + 1 : M); m0 += 8 * NGW) {
        v4u w[8][4]; float part[8];
#pragma unroll
        for (int i = 0; i < 8; ++i) { const int m = m0 + i * rows < M ? m0 + i * rows : m0; const v4u* hr = (const v4u*)(HB + (size_t)m * DM) + F.lane;
#pragma unroll
            for (int j = 0; j < 4; ++j) w[i][j] = hr[64 * j];
            part[i] = F.lane < 32 ? SS2[(size_t)m * 32 + F.lane] : 0.f; }
#pragma unroll
        for (int i = 0; i < 8; ++i) { const int m = m0 + i * rows; if (m >= M) break;
            const float rstd = 1.0f / sqrtf(wave_sum(part[i]) * (1.0f / DM) + 1e-6f);
            float* orow = F.out + (size_t)m * DM + 8 * F.lane;
#pragma unroll
            for (int j = 0; j < 4; ++j) {
                const f32x4 r0 = {__uint_as_float(w[i][j].x << 16), __uint_as_float(w[i][j].x & 0xffff0000u), __uint_as_float(w[i][j].y << 16), __uint_as_float(w[i][j].y & 0xffff0000u)};
                const f32x4 r1 = {__uint_as_float(w[i][j].z << 16), __uint_as_float(w[i][j].z & 0xffff0000u), __uint_as_float(w[i][j].w << 16), __uint_as_float(w[i][j].w & 0xffff0000u)};
                *(f32x4*)(orow + 512 * j) = r0 * rstd * g4[j][0]; *(f32x4*)(orow + 512 * j + 4) = r1 * rstd * g4[j][1]; } }
    }
}

constexpr int NPHASE = 8;
struct Args { const float* in[18]; float* out; unsigned char* ws; int ph_lo, ph_hi; };
__global__ void __launch_bounds__(NWAVES * 64, 2) fwd_kernel(Args args) {
    extern __shared__ __attribute__((aligned(16))) unsigned char lds_raw[];
    Frame F;
    asm volatile("s_nop 0\n\ts_nop 0\n\ts_nop 0\n\ts_nop 0\n\ts_nop 0\n\ts_nop 0");
    F.lds = (LAS unsigned char*)lds_raw;
    F.tid = threadIdx.x; F.lane = F.tid & 63; F.wave = __builtin_amdgcn_readfirstlane(F.tid >> 6); F.G = gridDim.x; F.bid = blockIdx.x;
#pragma unroll
    for (int i = 0; i < 18; ++i) F.in[i] = args.in[i];
    F.out = args.out; F.ws = args.ws;
    const int lo = args.ph_lo, hi = args.ph_hi;
#ifndef PROBE_REP
#define PROBE_REP -1
#endif
#define IN(k) (lo <= (k) && (k) < hi)
#define REP(k) for (int rep_ = 0; rep_ < ((k) == PROBE_REP ? 2 : 1); ++rep_)
#define SEAM(k) do { if (IN(k) && IN((k) + 1)) { xcd_barrier(bar); } } while (0)
    { volatile LAS unsigned* st = (volatile LAS unsigned*)(F.lds + LDS_MISC); if (F.tid < 4) st[F.tid] = 0u; }
    __syncthreads();
    XcdBarrier bar = xcd_barrier_post((unsigned*)(F.ws + WS_BAR), (volatile LAS unsigned*)(F.lds + LDS_MISC));
    if (lo > 1000) cg::this_grid().sync();
    bf16* PROJ = (bf16*)(F.ws + WS_PROJ);
    F.cv = F.bid; F.uni = 0;
    if (IN(0)) REP(0) { p0_prologue(F); } SEAM(0);
    if (IN(0) && IN(1)) { volatile LAS unsigned* st = (volatile LAS unsigned*)(F.lds + LDS_MISC); F.uni = (int)st[3]; if (F.uni) F.cv = (int)(bar.x + 8u * st[2]); }
#define SEAML(k) do { if (IN(k) && IN((k) + 1)) { if (F.uni) xcd_barrier_local(bar); else xcd_barrier(bar); } } while (0)
    if (IN(1)) REP(1) {
        pg8::Gemm g{(const pg8::bf16_t*)(F.ws + WS_H1B), (const pg8::bf16_t*)(F.ws + WS_WIN), M, NP, DM}; pg8::StaticOrder S; S.init(M, NP, F.G, F.cv);
        pg8::EpiProj E{PROJ, NP, 16, 20, att::QSCALE};
        pg8::gemm_phase<pg8::EpiProj, pg8::StaticOrder, true, true>(F.lds, g, S, E);
    } SEAM(1);
    if (IN(2)) REP(2) {
        dn::PreArgs A{PROJ, (const float*)(F.ws + WS_AB), F.in[3], F.in[4], F.in[5], (unsigned char*)F.out, F.ws + WS_U, (float*)(F.ws + WS_EG)};
        for (int it = F.bid * 8; it < BATCH * DNH * 64; it += F.G * 8) dn::dn_pre_block((LAS char*)F.lds, A, it);
    }
    unsigned* p2ctl = (unsigned*)(F.ws + WS_CTL + 4096);
    if (IN(2) && IN(3)) {
        asm volatile("s_waitcnt vmcnt(0)" ::: "memory"); __syncthreads();
        if (F.tid == 0) { const unsigned nloc = bar.st[0];
            if (xb_add(&p2ctl[64 * bar.x], 1u) + 1u == nloc) { __builtin_amdgcn_fence(__ATOMIC_RELEASE, "agent"); asm volatile("s_waitcnt vmcnt(0)" ::: "memory"); (void)xb_add(&p2ctl[1024], 1u); } }
    }
    if (IN(3)) REP(3) {
        if (F.bid < BATCH * DNH) {
            if (IN(2)) {
                if (F.tid == 0) { const unsigned nx = bar.st[1]; XB_SPIN(xb_ld(&p2ctl[1024]) < nx, bar.bar); __builtin_amdgcn_fence(__ATOMIC_ACQUIRE, "agent"); asm volatile("s_waitcnt vmcnt(0)" ::: "memory"); }
                __syncthreads();
            }
            dn::ScanArgs SA{(const unsigned char*)F.out, F.ws + WS_U, (const float*)(F.ws + WS_EG), PROJ, (bf16*)(F.ws + WS_MIX), F.in[6]};
            dn::dn_scan((LAS char*)F.lds, SA, F.bid);
        }
        if (F.G >= CONV_B0 + CONV_NB && F.bid >= CONV_B0 && F.bid < CONV_B0 + CONV_NB) {
            p0_convert_pipe(F, I_IN, NITEMS, (F.bid - CONV_B0) * NWAVES + F.wave, CONV_NB * NWAVES);
            __syncthreads();
        }
        att::AttnArgs A{PROJ, (bf16*)(F.ws + WS_MIX), F.in[11], F.in[12], F.in[7], F.in[8], F.in[9], F.in[10]};
        att::attn_setup((LAS char*)F.lds, A);
        unsigned* qctr = (unsigned*)(F.ws + WS_CTL);
        volatile LAS unsigned* qslot = (volatile LAS unsigned*)(F.lds + att::L_LAM + 16);
        for (;;) {
            if (F.tid == 0) *qslot = __hip_atomic_fetch_add(qctr, 1u, __ATOMIC_RELAXED, __HIP_MEMORY_SCOPE_AGENT);
            __syncthreads();
            const unsigned idx = *qslot;
            __syncthreads();
            if (idx >= 512u) break;
            const int bh = (int)(idx & 15u);
            att::attn_unit((LAS char*)F.lds, A, bh >> 2, bh & 3, 31 - (int)(idx >> 4));
        }
    } SEAM(3);
    if (IN(4)) REP(4) {
        pg8::Gemm g{(const pg8::bf16_t*)(F.ws + WS_MIX), (const pg8::bf16_t*)(F.ws + WS_WO), M, DM, DM}; pg8::StaticOrder S; S.init(M, DM, F.G, F.cv, 1);
        pg8::EpiOut E{(const float*)(F.ws + WS_IRS), (pg8::bf16_t*)(F.ws + WS_H1B), (float*)(F.ws + WS_SS1)};
        pg8::gemm_phase<pg8::EpiOut, pg8::StaticOrder, true, true>(F.lds, g, S, E);
    } SEAML(4);
    if (IN(5)) REP(5) {
        LAS float* rtab = (LAS float*)(F.lds + 131072); const int rbase = (F.cv & 7) * 2048;
        { const float* SS1 = (const float*)(F.ws + WS_SS1);
#pragma unroll
          for (int q4 = 0; q4 < 4; ++q4) {
              if (F.G == 256 && q4 > 0) break;
              const int r = F.G == 256 ? (4 * (F.tid >> 8) + ((F.cv >> 3) & 3)) * 256 + (F.tid & 255) : q4 * 512 + F.tid; const f32x4* sp = (const f32x4*)(SS1 + (size_t)(rbase + r) * 32);
              f32x4 t = sp[0];
#pragma unroll
              for (int i = 1; i < 8; ++i) t += sp[i];
              rtab[r] = 1.0f / sqrtf(((t[0] + t[1]) + (t[2] + t[3])) * (1.0f / 2048.0f) + 1e-6f); } }
        __syncthreads();
        pg8::Gemm g{(const pg8::bf16_t*)(F.ws + WS_H1B), (const pg8::bf16_t*)(F.ws + WS_WUP), M, FF, DM}; pg8::StaticOrder S; S.init(M, FF, F.G, F.cv);
        pg8::EpiUp E{(bf16*)(F.ws + WS_HID), rtab, rbase, (const float*)(F.ws + WS_SS1)};
        pg8::gemm_phase<pg8::EpiUp, pg8::StaticOrder, true, true>(F.lds, g, S, E);
    } SEAML(5);
    if (IN(6)) REP(6) {
        pg8::Gemm g{(const pg8::bf16_t*)(F.ws + WS_HID), (const pg8::bf16_t*)(F.ws + WS_WDN), M, DM, FF}; pg8::StaticOrder S; S.init(M, DM, F.G, F.cv, 1);
        pg8::EpiDown E{(pg8::bf16_t*)(F.ws + WS_H1B), (float*)(F.ws + WS_SS2)};
        pg8::gemm_phase<pg8::EpiDown, pg8::StaticOrder, true, true>(F.lds, g, S, E);
    } SEAML(6);
    if (IN(7)) REP(7) { final_norm_phase(F); }
#undef IN
#undef SEAM
}

#ifndef MK_ONE_LAUNCH
#define MK_ONE_LAUNCH 1
#endif
extern "C" void kernel_launch(void* const* d_in, const int* in_sizes, int n_in, void* d_out, int out_size, void* d_ws, size_t ws_size, hipStream_t stream) {
    static int grid = 0;
    if (grid == 0) {
        if (n_in != 18 || in_sizes[0] != M * DM || out_size != M * DM || ws_size < WS_END) { fprintf(stderr, "kernel_launch: unexpected shapes (n_in %d, in0 %d, out %d, ws %zu need %zu)\n", n_in, n_in > 0 ? in_sizes[0] : -1, out_size, ws_size, (size_t)WS_END); grid = -1; return; }
        int dev = 0, cus = 0, per_cu = 0;
        (void)hipGetDevice(&dev); (void)hipDeviceGetAttribute(&cus, hipDeviceAttributeMultiprocessorCount, dev);
        if (hipFuncSetAttribute((const void*)fwd_kernel, hipFuncAttributeMaxDynamicSharedMemorySize, LDS_BYTES) != hipSuccess) { fprintf(stderr, "kernel_launch: hipFuncSetAttribute failed\n"); grid = -1; return; }
        if (hipOccupancyMaxActiveBlocksPerMultiprocessor(&per_cu, (const void*)fwd_kernel, NWAVES * 64, LDS_BYTES) != hipSuccess || per_cu < 1) { fprintf(stderr, "kernel_launch: occupancy query says %d\n", per_cu); per_cu = 1; }
        (void)hipGetLastError();
        grid = cus > 0 ? cus : 256;
    }
    if (grid < 0) return;
    if (hipMemsetAsync((char*)d_ws + WS_CTL, 0, 128 * 1024, stream) != hipSuccess) { fprintf(stderr, "kernel_launch: hipMemsetAsync failed\n"); return; }
    Args a{};
    for (int i = 0; i < 18; ++i) a.in[i] = (const float*)d_in[i];
    a.out = (float*)d_out; a.ws = (unsigned char*)d_ws;
#if MK_ONE_LAUNCH
    a.ph_lo = 0; a.ph_hi = NPHASE;
    void* kargs[] = {&a};
    hipError_t e = hipLaunchCooperativeKernel((const void*)fwd_kernel, dim3(grid), dim3(NWAVES * 64), kargs, LDS_BYTES, stream);
    if (e != hipSuccess) fprintf(stderr, "kernel_launch: cooperative launch failed: %s\n", hipGetErrorString(e));
#else
    for (int p = 0; p < NPHASE; ++p) { a.ph_lo = p; a.ph_hi = p + 1; hipLaunchKernelGGL(fwd_kernel, dim3(grid), dim3(NWAVES * 64), LDS_BYTES, stream, a); }
#endif
}
```
